# Optimizing an MI355X kernel written in HIP

```python
import math
import jax, jax.numpy as jnp
from jax import lax
import numpy as np

D_MODEL = 2048
BATCH = 4
SEQ = 4096
DEPTH = 2

MIX_WIDTH = D_MODEL
DA_HEADS = 8
DA_HEAD_DIM = 64
DA_WIDTH = DA_HEADS * 2 * DA_HEAD_DIM
GDN_HEADS = 8
GDN_HEAD_DIM = 128
GDN_WIDTH = GDN_HEADS * GDN_HEAD_DIM
CONV_K = 4
GDN_CHUNK = 64
Q_BLOCK = 128
REL_BUCKETS = 32
REL_MAX_DIST = 128
RMS_EPS = 1e-6
NEG_INF = -1e30
IN_COLS = 4 * DA_WIDTH + 4 * GDN_WIDTH + 2 * GDN_HEADS

kernel_name = "hymba_diffattn_gdn_hybrid"


def rms_norm(x, g):
    xf = x.astype(jnp.float32)
    y = xf * lax.rsqrt(jnp.mean(xf * xf, axis=-1, keepdims=True) + RMS_EPS)
    return (y * g.astype(jnp.float32)).astype(x.dtype)


def l2_normalize(x):
    return x * lax.rsqrt(jnp.sum(x * x, axis=-1, keepdims=True) + RMS_EPS)


def t5_causal_bucket(dist):
    n = jnp.maximum(dist, 0)
    max_exact = REL_BUCKETS // 2
    large = max_exact + (jnp.log(jnp.maximum(n, max_exact).astype(jnp.float32) / max_exact)
                         / math.log(REL_MAX_DIST / max_exact)
                         * (REL_BUCKETS - max_exact)).astype(jnp.int32)
    large = jnp.minimum(large, REL_BUCKETS - 1)
    return jnp.where(n < max_exact, n, large)


def differential_attention(q1, q2, k1, k2, v, lam, rel_bias):
    B, H, T, _ = q1.shape
    n_blk = T // Q_BLOCK
    scale = DA_HEAD_DIM ** -0.5
    kpos = jnp.arange(T)

    def block(i):
        qs = i * Q_BLOCK
        q1b = lax.dynamic_slice_in_dim(q1, qs, Q_BLOCK, axis=2)
        q2b = lax.dynamic_slice_in_dim(q2, qs, Q_BLOCK, axis=2)
        dist = (qs + jnp.arange(Q_BLOCK))[:, None] - kpos[None, :]
        bias = jnp.transpose(rel_bias.astype(jnp.float32)[t5_causal_bucket(dist)], (2, 0, 1))
        causal = dist >= 0
        s1 = jnp.einsum('bhqd,bhkd->bhqk', q1b, k1).astype(jnp.float32) * scale + bias
        s2 = jnp.einsum('bhqd,bhkd->bhqk', q2b, k2).astype(jnp.float32) * scale + bias
        p1 = jax.nn.softmax(jnp.where(causal, s1, NEG_INF), axis=-1)
        p2 = jax.nn.softmax(jnp.where(causal, s2, NEG_INF), axis=-1)
        attn = p1 - lam * p2
        return jnp.einsum('bhqk,bhkv->bhqv', attn.astype(v.dtype), v)

    out = lax.map(block, jnp.arange(n_blk))
    return jnp.transpose(out, (1, 2, 0, 3, 4)).reshape(B, H, T, v.shape[-1])


def causal_depthwise_conv(x, w):
    T = x.shape[1]
    xp = jnp.pad(x, ((0, 0), (CONV_K - 1, 0), (0, 0)))
    y = xp[:, 0:T] * w[0]
    for j in range(1, CONV_K):
        y = y + xp[:, j:j + T] * w[j]
    return y


def gated_delta_rule_chunked(q, k, v, g, beta):
    B, H, T, dk = q.shape
    dv = v.shape[-1]
    C = GDN_CHUNK
    N = T // C
    q = q.reshape(B, H, N, C, dk)
    k = k.reshape(B, H, N, C, dk)
    v = v.reshape(B, H, N, C, dv)
    beta = beta.reshape(B, H, N, C)
    g = jnp.cumsum(g.reshape(B, H, N, C), axis=-1)
    tril = jnp.tril(jnp.ones((C, C), dtype=bool))
    strict = jnp.tril(jnp.ones((C, C), dtype=bool), -1)
    diff = g[..., :, None] - g[..., None, :]
    decay = jnp.where(tril, jnp.exp(jnp.where(tril, diff, 0.0)), 0.0)
    kb = k * beta[..., None]
    vb = v * beta[..., None]
    L = jnp.where(strict, jnp.einsum('bhnid,bhnjd->bhnij', kb, k) * decay, 0.0)
    A = L + jnp.eye(C, dtype=jnp.float32)
    rhs = jnp.concatenate([vb, kb * jnp.exp(g)[..., None]], axis=-1)
    sol = lax.linalg.triangular_solve(A, rhs, left_side=True, lower=True)
    u, w = sol[..., :dv], sol[..., dv:]
    qk = jnp.where(tril, jnp.einsum('bhnid,bhnjd->bhnij', q, k) * decay, 0.0)
    g_last = g[..., -1]

    def step(S, inp):
        qc, kc, uc, wc, qkc, gc, glc = inp
        v_new = uc - jnp.einsum('bhcd,bhdv->bhcv', wc, S)
        o = (jnp.einsum('bhcd,bhdv->bhcv', qc * jnp.exp(gc)[..., None], S)
             + jnp.einsum('bhij,bhjv->bhiv', qkc, v_new))
        S = (S * jnp.exp(glc)[..., None, None]
             + jnp.einsum('bhcd,bhcv->bhdv', kc * jnp.exp(glc[..., None] - gc)[..., None], v_new))
        return S, o

    mv = lambda t: jnp.moveaxis(t, 2, 0)
    S0 = jnp.zeros((B, H, dk, dv), jnp.float32)
    _, o = lax.scan(step, S0, (mv(q), mv(k), mv(u), mv(w), mv(qk), mv(g), mv(g_last)))
    return jnp.moveaxis(o, 0, 2).reshape(B, H, T, dv)


def hybrid_layer(x, norm_w, w_in, w_out, lq1, lk1, lq2, lk2, subln_w, rel_bias,
                 conv_w, a_log, dt_bias, gdn_norm_w, lambda_init):
    B, T, _ = x.shape
    h = rms_norm(x, norm_w)
    proj = jnp.einsum('btd,dc->btc', h, w_in)

    def heads_pair(t):
        t = t.reshape(B, T, DA_HEADS, 2, DA_HEAD_DIM)
        return jnp.transpose(t[..., 0, :], (0, 2, 1, 3)), jnp.transpose(t[..., 1, :], (0, 2, 1, 3))
    q1, q2 = heads_pair(proj[..., 0:DA_WIDTH])
    k1, k2 = heads_pair(proj[..., DA_WIDTH:2 * DA_WIDTH])
    v_da = jnp.transpose(proj[..., 2 * DA_WIDTH:3 * DA_WIDTH].reshape(B, T, DA_HEADS, 2 * DA_HEAD_DIM), (0, 2, 1, 3))
    gate_da = proj[..., 3 * DA_WIDTH:4 * DA_WIDTH]
    lam = (jnp.exp(jnp.sum(lq1.astype(jnp.float32) * lk1.astype(jnp.float32)))
           - jnp.exp(jnp.sum(lq2.astype(jnp.float32) * lk2.astype(jnp.float32)))
           + lambda_init)
    o_da = differential_attention(q1, q2, k1, k2, v_da, lam, rel_bias)
    o_da = rms_norm(o_da, subln_w) * (1.0 - lambda_init)
    o_da = jnp.transpose(o_da, (0, 2, 1, 3)).reshape(B, T, DA_WIDTH)
    o_da = (o_da * jax.nn.silu(gate_da)).astype(x.dtype)

    off = 4 * DA_WIDTH
    qkv = proj[..., off:off + 3 * GDN_WIDTH]
    z = proj[..., off + 3 * GDN_WIDTH:off + 4 * GDN_WIDTH]
    b_raw = proj[..., off + 4 * GDN_WIDTH:off + 4 * GDN_WIDTH + GDN_HEADS]
    a_raw = proj[..., off + 4 * GDN_WIDTH + GDN_HEADS:off + 4 * GDN_WIDTH + 2 * GDN_HEADS]
    qkv = jax.nn.silu(causal_depthwise_conv(qkv, conv_w)).astype(jnp.float32)
    to_heads = lambda t: jnp.transpose(t.reshape(B, T, GDN_HEADS, GDN_HEAD_DIM), (0, 2, 1, 3))
    q = l2_normalize(to_heads(qkv[..., 0:GDN_WIDTH])) * (GDN_HEAD_DIM ** -0.5)
    k = l2_normalize(to_heads(qkv[..., GDN_WIDTH:2 * GDN_WIDTH]))
    v = to_heads(qkv[..., 2 * GDN_WIDTH:3 * GDN_WIDTH])
    beta = jnp.transpose(jax.nn.sigmoid(b_raw.astype(jnp.float32)), (0, 2, 1))
    g = -jnp.exp(a_log.astype(jnp.float32)) * jax.nn.softplus(a_raw.astype(jnp.float32) + dt_bias.astype(jnp.float32))
    g = jnp.transpose(g, (0, 2, 1))
    o_gdn = gated_delta_rule_chunked(q, k, v, g, beta)
    o_gdn = rms_norm(jnp.transpose(o_gdn, (0, 2, 1, 3)), gdn_norm_w)
    o_gdn = o_gdn * jax.nn.silu(z.astype(jnp.float32)).reshape(B, T, GDN_HEADS, GDN_HEAD_DIM)
    o_gdn = o_gdn.reshape(B, T, GDN_WIDTH).astype(x.dtype)

    mixed = jnp.concatenate([o_da, o_gdn], axis=-1)
    return x + jnp.einsum('btc,cd->btd', mixed, w_out).astype(x.dtype)


def setup_inputs(seed: int = 0) -> dict:
    key = jax.random.key(seed)
    ks = jax.random.split(key, 16)
    f32 = jnp.float32
    x = jax.random.normal(ks[0], (BATCH, SEQ, D_MODEL), f32)
    norm_w = 1.0 + 0.02 * jax.random.normal(ks[1], (DEPTH, D_MODEL), f32)
    w_in = jax.random.normal(ks[2], (DEPTH, D_MODEL, IN_COLS), f32) * (D_MODEL ** -0.5)
    w_out = jax.random.normal(ks[3], (DEPTH, MIX_WIDTH, D_MODEL), f32) * (MIX_WIDTH ** -0.5)
    lambda_q1 = 0.1 * jax.random.normal(ks[4], (DEPTH, DA_HEAD_DIM), f32)
    lambda_k1 = 0.1 * jax.random.normal(ks[5], (DEPTH, DA_HEAD_DIM), f32)
    lambda_q2 = 0.1 * jax.random.normal(ks[6], (DEPTH, DA_HEAD_DIM), f32)
    lambda_k2 = 0.1 * jax.random.normal(ks[7], (DEPTH, DA_HEAD_DIM), f32)
    da_subln_w = 1.0 + 0.02 * jax.random.normal(ks[8], (DEPTH, 2 * DA_HEAD_DIM), f32)
    rel_bias = 0.5 * jax.random.normal(ks[9], (REL_BUCKETS, DA_HEADS), f32)
    conv_w = jax.random.normal(ks[10], (DEPTH, CONV_K, 3 * GDN_WIDTH), f32) * (CONV_K ** -0.5)
    a_log = jnp.log(jax.random.uniform(ks[11], (DEPTH, GDN_HEADS), f32, 1.0, 16.0))
    dt_bias = 0.1 * jax.random.normal(ks[12], (DEPTH, GDN_HEADS), f32)
    gdn_norm_w = 1.0 + 0.02 * jax.random.normal(ks[13], (DEPTH, GDN_HEAD_DIM), f32)
    final_norm_w = 1.0 + 0.02 * jax.random.normal(ks[14], (D_MODEL,), f32)
    return {"x": x, "norm_w": norm_w, "w_in": w_in, "w_out": w_out,
            "lambda_q1": lambda_q1, "lambda_k1": lambda_k1, "lambda_q2": lambda_q2, "lambda_k2": lambda_k2,
            "da_subln_w": da_subln_w, "rel_bias": rel_bias, "conv_w": conv_w, "a_log": a_log,
            "dt_bias": dt_bias, "gdn_norm_w": gdn_norm_w, "final_norm_w": final_norm_w}


def reference(x, norm_w, w_in, w_out, lambda_q1, lambda_k1, lambda_q2, lambda_k2,
              da_subln_w, rel_bias, conv_w, a_log, dt_bias, gdn_norm_w, final_norm_w):
    for l in range(DEPTH):
        lambda_init = 0.8 - 0.6 * math.exp(-0.3 * l)
        x = hybrid_layer(x, norm_w[l], w_in[l], w_out[l],
                         lambda_q1[l], lambda_k1[l], lambda_q2[l], lambda_k2[l],
                         da_subln_w[l], rel_bias, conv_w[l], a_log[l], dt_bias[l], gdn_norm_w[l],
                         lambda_init)
    return rms_norm(x, final_norm_w)
```

```cpp
#include <hip/hip_runtime.h>
#include <hip/hip_cooperative_groups.h>
#include <cstdio>
#include <cstdint>
namespace cg = cooperative_groups;
namespace pg8 {
#define PG8_LAS __attribute__((address_space(3)))
typedef unsigned short bf16_t;
typedef short bf16x8 __attribute__((ext_vector_type(8)));
typedef float f32x4 __attribute__((ext_vector_type(4)));
typedef unsigned u32x4 __attribute__((ext_vector_type(4)));
constexpr int BM = 256, BK = 64, HALF = 128, HTB = HALF * BK * 2  , STAGE_BYTES = 8 * HTB, NXCD = 8, WGM = 8;

__host__ __device__ __forceinline__ int lds_byte(int r, int c) { const int st = (r >> 4) * 2 + (c >> 5), rr = r & 15, cc = c & 31, ob = rr * 64 + cc * 2; return st * 1024 + (ob ^ (((ob >> 9) & 1) << 5)); }
__host__ __device__ __forceinline__ void stage_rc(int b, int& R, int& C) { const int st = b / 1024, sb = b % 1024, swz = sb ^ (((sb >> 9) & 1) << 5); R = (st >> 1) * 16 + swz / 64; C = (st & 1) * 32 + (swz % 64) / 2; }
__host__ __device__ __forceinline__ int perm32(int rho) { const int n = rho >> 4, i = rho & 15; return 8 * (i >> 2) + 4 * n + (i & 3); }

struct Unit { int pm, pn; };
struct Gemm { const bf16_t* A; const bf16_t* Bt; int M, N, K; };

struct StaticOrder {
    int nM, nN, nwg, G, c;
    __host__ __device__ void init(int M, int N, int G_, int c_) { nM = M / BM; nN = N / BM; nwg = nM * nN; G = G_; c = c_; }
    __host__ __device__ bool next(int i, Unit& u) const {
        const long L = (long)i * G + c; if (L >= nwg) return false;
        int wgid = (int)L; { const int q = nwg / NXCD, r = nwg % NXCD, xcd = wgid % NXCD, off = wgid / NXCD; wgid = (xcd < r ? xcd * (q + 1) : r * (q + 1) + (xcd - r) * q) + off; }
        const int nig = WGM * nN, gid = wgid / nig, fm = gid * WGM, gsz = (nM - fm) < WGM ? (nM - fm) : WGM;
        u.pm = fm + ((wgid % nig) % gsz); u.pn = (wgid % nig) / gsz; return true;
    }
    __device__ __forceinline__ void a_ready(const Unit&) const {}
    __device__ __forceinline__ void done(const Unit&) const {}
};


__device__ __forceinline__ unsigned cvt_pk_bf16(float lo, float hi) { unsigned r; asm volatile("v_cvt_pk_bf16_f32 %0, %1, %2" : "=v"(r) : "v"(lo), "v"(hi)); return r; }
typedef unsigned u32x2 __attribute__((ext_vector_type(2)));

struct EpiProj {
    static constexpr bool PERM = true, AFTER_DRAIN = false, IDEMPOTENT = true;
    bf16_t* O; const PG8_LAS float* rstd; float qscale;
    __device__ __forceinline__ void operator()(const f32x4 (&acc)[2][2][4][2], const Unit& u, int wr, int wc, int fr, int fq) const {
        const int col0 = u.pn * BM + wc * 32 + 8 * fq;
        const float sc = (u.pn < 4) ? qscale : 1.f;
        const bool act = (u.pn >= 12 && u.pn < 16) || (u.pn >= 28);
#pragma unroll
        for (int ai = 0; ai < 2; ++ai)
#pragma unroll
            for (int m = 0; m < 4; ++m) { const int r = ai * HALF + wr * 64 + m * 16 + fr; const float s = rstd[r] * sc;
                bf16_t* rowp = O + ((size_t)((u.pm * 4 + ai * 2 + wr) * 256 + u.pn * 8 + wc) * 2048 + (m * 16 + fr) * 32 + 8 * fq);
#pragma unroll
                for (int bj = 0; bj < 2; ++bj) { f32x4 v0 = acc[ai][bj][m][0] * s, v1 = acc[ai][bj][m][1] * s;
                    if (act) { typedef float f32x2p __attribute__((ext_vector_type(2)));
                        _Pragma("unroll") for (int e_ = 0; e_ < 4; e_ += 2) { f32x2p a = {v0[e_], v0[e_ + 1]}, c = {v1[e_], v1[e_ + 1]};
                            f32x2p ea = a * (f32x2p){-1.4426950408889634f, -1.4426950408889634f}, ec = c * (f32x2p){-1.4426950408889634f, -1.4426950408889634f};
                            ea = (f32x2p){__builtin_amdgcn_exp2f(ea.x), __builtin_amdgcn_exp2f(ea.y)} + (f32x2p){1.f, 1.f}; ec = (f32x2p){__builtin_amdgcn_exp2f(ec.x), __builtin_amdgcn_exp2f(ec.y)} + (f32x2p){1.f, 1.f};
                            a = a * (f32x2p){__builtin_amdgcn_rcpf(ea.x), __builtin_amdgcn_rcpf(ea.y)}; c = c * (f32x2p){__builtin_amdgcn_rcpf(ec.x), __builtin_amdgcn_rcpf(ec.y)};
                            v0[e_] = a.x; v0[e_ + 1] = a.y; v1[e_] = c.x; v1[e_ + 1] = c.y; } }
                    u32x4 w; w.x = cvt_pk_bf16(v0[0], v0[1]); w.y = cvt_pk_bf16(v0[2], v0[3]); w.z = cvt_pk_bf16(v1[0], v1[1]); w.w = cvt_pk_bf16(v1[2], v1[3]);
                    *(u32x4*)(rowp + bj * 4 * 2048) = w;
                } }
    }
};
template <bool RES_BF16> struct EpiOut {
    static constexpr bool PERM = true, AFTER_DRAIN = false, IDEMPOTENT = !RES_BF16;
    const float* res; bf16_t* xb; float* rowsq;
    __device__ __forceinline__ void operator()(const f32x4 (&acc)[2][2][4][2], const Unit& u, int wr, int wc, int fr, int fq) const {
        u32x4 rbv[2][4][2];
        if constexpr (RES_BF16) {
#pragma unroll
            for (int ai = 0; ai < 2; ++ai)
#pragma unroll
                for (int m = 0; m < 4; ++m) { const bf16_t* bp = xb + ((size_t)((u.pm * 4 + ai * 2 + wr) * 64 + u.pn * 8 + wc) * 2048 + (m * 16 + fr) * 32 + 8 * fq);
                    rbv[ai][m][0] = *(const u32x4*)bp; rbv[ai][m][1] = *(const u32x4*)(bp + 4 * 2048); }
            asm volatile("" ::: "memory"); }
        const int col0 = u.pn * BM + wc * 32 + 8 * fq;
#pragma unroll
        for (int ai = 0; ai < 2; ++ai)
#pragma unroll
            for (int m = 0; m < 4; ++m) { const int row = u.pm * BM + ai * HALF + wr * 64 + m * 16 + fr; float ss = 0.f;
                bf16_t* bp = xb + ((size_t)((u.pm * 4 + ai * 2 + wr) * 64 + u.pn * 8 + wc) * 2048 + (m * 16 + fr) * 32 + 8 * fq);
#pragma unroll
                for (int bj = 0; bj < 2; ++bj) { f32x4 r0, r1;
                    if constexpr (RES_BF16) { const u32x4 rb = rbv[ai][m][bj];
                        r0 = (f32x4){__uint_as_float(rb.x << 16), __uint_as_float(rb.x & 0xffff0000u), __uint_as_float(rb.y << 16), __uint_as_float(rb.y & 0xffff0000u)};
                        r1 = (f32x4){__uint_as_float(rb.z << 16), __uint_as_float(rb.z & 0xffff0000u), __uint_as_float(rb.w << 16), __uint_as_float(rb.w & 0xffff0000u)}; }
                    else { const float* rp = res + (size_t)row * 2048 + col0 + bj * HALF; r0 = *(const f32x4*)rp; r1 = *(const f32x4*)(rp + 4); }
                    const f32x4 v0 = r0 + acc[ai][bj][m][0], v1 = r1 + acc[ai][bj][m][1];
                    u32x4 w; w.x = cvt_pk_bf16(v0[0], v0[1]); w.y = cvt_pk_bf16(v0[2], v0[3]); w.z = cvt_pk_bf16(v1[0], v1[1]); w.w = cvt_pk_bf16(v1[2], v1[3]);
                    *(u32x4*)(bp + bj * 4 * 2048) = w;
                    ss += ((v0[0] * v0[0] + v0[1] * v0[1]) + (v0[2] * v0[2] + v0[3] * v0[3])) + ((v1[0] * v1[0] + v1[1] * v1[1]) + (v1[2] * v1[2] + v1[3] * v1[3])); }
                ss += __builtin_bit_cast(float, __builtin_amdgcn_ds_swizzle(__builtin_bit_cast(int, ss), (16 << 10) | 0x1F));
                { auto rr = __builtin_amdgcn_permlane32_swap(__float_as_uint(ss), __float_as_uint(ss), false, false); ss = __uint_as_float(rr[0]) + __uint_as_float(rr[1]); }
                if (fq == 0) rowsq[(size_t)row * 32 + u.pn * 4 + wc] = ss; }
    }
};

template <class Epi, class Sched, bool ALIGN_EPI = false, bool SP2 = false>
__device__ __forceinline__ void gemm_phase(PG8_LAS unsigned char* lds, const Gemm g, const Sched& S, const Epi& E, const int wave_id) {
    int lane_; asm volatile("v_mbcnt_lo_u32_b32 %0, -1, 0\n\tv_mbcnt_hi_u32_b32 %0, -1, %0" : "=v"(lane_));
    const int wid = wave_id, tid = wid * 64 + lane_, lane = lane_, wr = wid >> 2, wc = wid & 3, fr = lane & 15, fq = lane >> 4;
    const int K = g.K, nt = K / BK;
    unsigned voffA[2], voffB[2];
#pragma unroll
    for (int i = 0; i < 2; ++i) { int R, C; stage_rc(tid * 16 + i * 8192, R, C); const int Rb = Epi::PERM ? ((R & ~31) + perm32(R & 31)) : R;
        voffA[i] = (unsigned)(((R >> 6) * (K / 32) + (C >> 5)) * 2048 + (R & 63) * 32 + (C & 31)) * 2u; voffB[i] = (unsigned)(((Rb >> 6) * (K / 32) + (C >> 5)) * 2048 + (Rb & 63) * 32 + (C & 31)) * 2u; }
    const size_t kstep = (size_t)(2 * 2048 * 2);
    const size_t kstepA = (size_t)(2 * 2048 * 2);
    const size_t hstep = (size_t)HALF * K * 2;
    const size_t tstep = 2 * hstep;
    const unsigned ldsw = (unsigned)wid * 1024u;
    const int aoff = lds_byte(wr * 64 + fr, fq * 8), boff = lds_byte(wc * 32 + fr, fq * 8);
#define PG8_SA(b, h) (((b) * 2 + (h)) * HTB)
#define PG8_SB(b, h) ((4 + (b) * 2 + (h)) * HTB)
#define PG8_STAGE(bufoff, gbase, voff) do { _Pragma("unroll") for (int _i = 0; _i < 2; ++_i) \
        __builtin_amdgcn_global_load_lds((const unsigned*)((const char*)(gbase) + (voff)[_i]), (PG8_LAS unsigned*)(lds + (bufoff) + ldsw + _i * 8192), 16, 0, 0); } while (0)
#define PG8_LDA(dst, b, h) do { _Pragma("unroll") for (int m = 0; m < 4; ++m) _Pragma("unroll") for (int k = 0; k < 2; ++k) dst[m][k] = *(const PG8_LAS bf16x8*)(lds + PG8_SA(b, h) + aoff + m * 2048 + k * 1024); } while (0)
#define PG8_LDB(dst, b, h) do { _Pragma("unroll") for (int n = 0; n < 2; ++n) _Pragma("unroll") for (int k = 0; k < 2; ++k) dst[n][k] = *(const PG8_LAS bf16x8*)(lds + PG8_SB(b, h) + boff + n * 2048 + k * 1024); } while (0)
#define PG8_MMA(ai, bj, At, Bt) do { __builtin_amdgcn_s_setprio(1); _Pragma("unroll") for (int m = 0; m < 4; ++m) _Pragma("unroll") for (int n = 0; n < 2; ++n) _Pragma("unroll") for (int k = 0; k < 2; ++k) \
        acc[ai][bj][m][n] = __builtin_amdgcn_mfma_f32_16x16x32_bf16(Bt[n][k], At[m][k], acc[ai][bj][m][n], 0, 0, 0); __builtin_amdgcn_s_setprio(0); } while (0)
#define PG8_WAIT_V(n) asm volatile("s_waitcnt vmcnt(" #n ")" ::: "memory")
#define PG8_WAIT_L(n) asm volatile("s_waitcnt lgkmcnt(" #n ")" ::: "memory")
#define PG8_BAR __builtin_amdgcn_s_barrier()
#define PG8_SCHED __builtin_amdgcn_sched_barrier(0)
    Unit cur, nxt; int ui = 0;
    if (!S.next(0, cur)) return;
    f32x4 acc[2][2][4][2];
#pragma unroll
    for (int a = 0; a < 2; ++a)
#pragma unroll
        for (int b = 0; b < 2; ++b)
#pragma unroll
            for (int m = 0; m < 4; ++m)
#pragma unroll
                for (int n = 0; n < 2; ++n) acc[a][b][m][n] = (f32x4){0.f, 0.f, 0.f, 0.f};
    bf16x8 At[4][2], B0[2][2], B1[2][2];
    const char* cA = (const char*)g.A + (size_t)cur.pm * tstep; const char* cB = (const char*)g.Bt + (size_t)cur.pn * tstep;
    S.a_ready(cur);
    if constexpr (SP2) {
        PG8_STAGE(PG8_SB(0, 0), cB, voffB); PG8_STAGE(PG8_SB(0, 1), cB + hstep, voffB); PG8_STAGE(PG8_SA(0, 0), cA, voffA); PG8_STAGE(PG8_SA(0, 1), cA + hstep, voffA);
        if (wr == 1) PG8_BAR;
        PG8_WAIT_V(2); PG8_BAR;
        PG8_STAGE(PG8_SB(1, 0), cB + kstep, voffB); PG8_STAGE(PG8_SA(1, 0), cA + kstepA, voffA); PG8_STAGE(PG8_SB(1, 1), cB + hstep + kstep, voffB);
        PG8_WAIT_V(6); PG8_BAR;
    } else {
        PG8_STAGE(PG8_SB(0, 0), cB, voffB); PG8_STAGE(PG8_SA(0, 0), cA, voffA); PG8_STAGE(PG8_SB(0, 1), cB + hstep, voffB); PG8_STAGE(PG8_SA(0, 1), cA + hstep, voffA);
        if (wr == 1) PG8_BAR;
        PG8_WAIT_V(4); PG8_BAR;
        PG8_STAGE(PG8_SB(1, 0), cB + kstep, voffB); PG8_STAGE(PG8_SA(1, 0), cA + kstepA, voffA); PG8_STAGE(PG8_SB(1, 1), cB + hstep + kstep, voffB);
        PG8_WAIT_V(6); PG8_BAR;
    }
    for (;;) {
        const bool has_next = S.next(ui + 1, nxt);
        const char* nA = has_next ? (const char*)g.A + (size_t)nxt.pm * tstep : cA; const char* nB = has_next ? (const char*)g.Bt + (size_t)nxt.pn * tstep : cB;
        for (int t = 0; t < nt; t += 2) {
            const bool last = (t == nt - 2);
            const char* a1 = cA + (size_t)(t + 1) * kstepA;
            const char* a2 = last ? nA : cA + (size_t)(t + 2) * kstepA; const char* b2 = last ? nB : cB + (size_t)(t + 2) * kstep;
            const char* a3 = a2 + kstepA; const char* b3 = b2 + kstep;
            if (last && has_next) S.a_ready(nxt);
            if constexpr (SP2) {
            PG8_LDB(B0, 0, 0); PG8_LDB(B1, 0, 1); PG8_SCHED; PG8_LDA(At, 0, 0); PG8_STAGE(PG8_SA(1, 1), a1 + hstep, voffA);
            PG8_WAIT_V(8); PG8_WAIT_L(0); PG8_BAR; PG8_MMA(0, 0, At, B0); PG8_MMA(0, 1, At, B1); PG8_BAR; PG8_SCHED;
            PG8_LDA(At, 0, 1); PG8_STAGE(PG8_SB(0, 0), b2, voffB); PG8_STAGE(PG8_SB(0, 1), b2 + hstep, voffB); PG8_STAGE(PG8_SA(0, 0), a2, voffA);
            PG8_WAIT_V(8); PG8_WAIT_L(0); PG8_BAR; PG8_MMA(1, 0, At, B0); PG8_MMA(1, 1, At, B1); PG8_BAR; PG8_SCHED;
            PG8_LDB(B0, 1, 0); PG8_LDB(B1, 1, 1); PG8_SCHED; PG8_LDA(At, 1, 0); PG8_STAGE(PG8_SA(0, 1), a2 + hstep, voffA);
            PG8_WAIT_V(8); PG8_WAIT_L(0); PG8_BAR; PG8_MMA(0, 0, At, B0); PG8_MMA(0, 1, At, B1); PG8_BAR; PG8_SCHED;
            PG8_LDA(At, 1, 1); PG8_STAGE(PG8_SB(1, 0), b3, voffB); PG8_STAGE(PG8_SB(1, 1), b3 + hstep, voffB); PG8_STAGE(PG8_SA(1, 0), a3, voffA);
            PG8_WAIT_V(8); PG8_WAIT_L(0); PG8_BAR; PG8_MMA(1, 0, At, B0); PG8_MMA(1, 1, At, B1); PG8_BAR; PG8_SCHED;
            } else {
            PG8_LDB(B0, 0, 0); PG8_SCHED; PG8_LDA(At, 0, 0); PG8_STAGE(PG8_SA(1, 1), a1 + hstep, voffA);
            PG8_WAIT_L(8); PG8_BAR; PG8_WAIT_L(0); PG8_MMA(0, 0, At, B0); PG8_BAR; PG8_SCHED;
            PG8_LDB(B1, 0, 1); PG8_STAGE(PG8_SB(0, 0), b2, voffB);
            PG8_BAR; PG8_WAIT_L(0); PG8_MMA(0, 1, At, B1); PG8_BAR;
            PG8_LDA(At, 0, 1); PG8_STAGE(PG8_SA(0, 0), a2, voffA);
            PG8_BAR; PG8_WAIT_L(0); PG8_MMA(1, 0, At, B0); PG8_BAR; PG8_SCHED;
            PG8_STAGE(PG8_SB(0, 1), b2 + hstep, voffB);
            PG8_WAIT_V(6); PG8_BAR; PG8_MMA(1, 1, At, B1); PG8_BAR;
            PG8_LDB(B0, 1, 0); PG8_SCHED; PG8_LDA(At, 1, 0); PG8_STAGE(PG8_SA(0, 1), a2 + hstep, voffA);
            PG8_WAIT_L(8); PG8_BAR; PG8_WAIT_L(0); PG8_MMA(0, 0, At, B0); PG8_BAR; PG8_SCHED;
            PG8_LDB(B1, 1, 1); PG8_STAGE(PG8_SB(1, 0), b3, voffB);
            PG8_BAR; PG8_WAIT_L(0); PG8_MMA(0, 1, At, B1); PG8_BAR;
            PG8_LDA(At, 1, 1); PG8_STAGE(PG8_SA(1, 0), a3, voffA);
            PG8_BAR; PG8_WAIT_L(0); PG8_MMA(1, 0, At, B0); PG8_BAR; PG8_SCHED;
            PG8_STAGE(PG8_SB(1, 1), b3 + hstep, voffB);
            PG8_WAIT_V(6); PG8_BAR; PG8_MMA(1, 1, At, B1); PG8_BAR;
            }
        }
        if constexpr (ALIGN_EPI) { if (wr == 0) PG8_BAR; }
#ifndef REP_EPI
#define REP_EPI 1
#endif
        if constexpr (!Epi::AFTER_DRAIN) { for (int re_ = 0; re_ < (Epi::IDEMPOTENT ? REP_EPI : 1); ++re_) E(acc, cur, wr, wc, fr, fq); S.done(cur); }
        if (!has_next) break;
#pragma unroll
        for (int a = 0; a < 2; ++a)
#pragma unroll
            for (int b = 0; b < 2; ++b)
#pragma unroll
                for (int m = 0; m < 4; ++m)
#pragma unroll
                    for (int n = 0; n < 2; ++n) acc[a][b][m][n] = (f32x4){0.f, 0.f, 0.f, 0.f};
        cur = nxt; cA = nA; cB = nB; ++ui;
        if constexpr (ALIGN_EPI) { if (wr == 1) PG8_BAR; }
    }
    PG8_WAIT_V(0);
    if constexpr (!ALIGN_EPI) { if (wr == 0) PG8_BAR; }
    PG8_BAR;
    if constexpr (Epi::AFTER_DRAIN) { E.fused(acc, cur, wr, wc, fr, fq, lds, wid, lane); S.done(cur); }
#undef PG8_SA
#undef PG8_SB
#undef PG8_STAGE
#undef PG8_LDA
#undef PG8_LDB
#undef PG8_MMA
#undef PG8_WAIT_V
#undef PG8_WAIT_L
#undef PG8_BAR
#undef PG8_SCHED
}
}

#define LAS __attribute__((address_space(3)))
typedef unsigned short bf16_t;
typedef short bf16x8 __attribute__((ext_vector_type(8)));
typedef short s16x4 __attribute__((ext_vector_type(4)));
typedef float f32x4 __attribute__((ext_vector_type(4)));
typedef float f32x16 __attribute__((ext_vector_type(16)));
typedef unsigned u32x4 __attribute__((ext_vector_type(4)));
typedef unsigned u32x2 __attribute__((ext_vector_type(2)));

constexpr int BATCH = 4, SEQ = 4096, DM = 2048, M = BATCH * SEQ, NH = 8;
constexpr int IN_COLS = 8208, NPROJ = 8192;
constexpr size_t PJ_RB = 256 * 2048;
__host__ __device__ __forceinline__ size_t pj2(size_t row, int col) { return ((row >> 6) * 64 + (size_t)(col >> 5)) * 2048 + (row & 63) * 32 + (col & 31); }
__host__ __device__ __forceinline__ size_t pj(size_t row, int col) { return ((row >> 6) * 256 + (size_t)(col >> 5)) * 2048 + (row & 63) * 32 + (col & 31); }
constexpr int C_DAQ = 0, C_DAK = 1024, C_DAV = 2048, C_DAG = 3072, C_GQ = 4096, C_GK = 5120, C_GV = 6144, C_GZ = 7168;
constexpr float RMS_EPS = 1e-6f;
constexpr float LOG2E = 1.4426950408889634f;
constexpr float QSCALE = 0.125f * LOG2E;

constexpr size_t MiB = 1u << 20;
constexpr size_t WS_CTL = 0;
constexpr size_t WS_WIN = 1 * MiB;
constexpr size_t WS_WBA = 65 * MiB;
constexpr size_t WS_WOUT = 66 * MiB;
constexpr size_t WS_XB = 82 * MiB;
constexpr size_t WS_PROJ = 146 * MiB;
constexpr size_t WS_MIXED = 402 * MiB;
constexpr size_t WS_VN = 466 * MiB;
constexpr size_t WS_ROWSQ = 498 * MiB;
constexpr size_t WS_BA = 500 * MiB;
constexpr size_t WS_GB = 501 * MiB;
constexpr size_t WS_END = 502 * MiB;

constexpr int RING_BYTES = 131072;
constexpr int LDSX_OFF = RING_BYTES;
constexpr int LDS_BYTES = 163840;
constexpr int LDS_BARST = 163584;

__device__ __forceinline__ unsigned cvtpk(float lo, float hi) { unsigned r; asm volatile("v_cvt_pk_bf16_f32 %0, %1, %2" : "=v"(r) : "v"(lo), "v"(hi)); return r; }
__device__ __forceinline__ float bf_lo(unsigned w) { return __uint_as_float(w << 16); }
__device__ __forceinline__ float bf_hi(unsigned w) { return __uint_as_float(w & 0xffff0000u); }
template <int K> __device__ __forceinline__ float shx(float v) {
    const int x = __builtin_bit_cast(int, v);
    if constexpr (K == 1) return __builtin_bit_cast(float, __builtin_amdgcn_update_dpp(x, x, 0xB1, 0xF, 0xF, true));
    else if constexpr (K == 2) return __builtin_bit_cast(float, __builtin_amdgcn_update_dpp(x, x, 0x4E, 0xF, 0xF, true));
    else if constexpr (K == 32) { auto rr = __builtin_amdgcn_permlane32_swap((unsigned)x, (unsigned)x, false, false);
        return __builtin_bit_cast(float, (__builtin_amdgcn_mbcnt_hi(-1, 0) != 0) ? rr[0] : rr[1]); }
    else return __builtin_bit_cast(float, __builtin_amdgcn_ds_swizzle(x, (K << 10) | 0x1F));
}
__device__ __forceinline__ float rsum16(float v) {
    int x = __builtin_bit_cast(int, v); v += __builtin_bit_cast(float, __builtin_amdgcn_update_dpp(x, x, 0x128, 0xF, 0xF, true));
    x = __builtin_bit_cast(int, v); v += __builtin_bit_cast(float, __builtin_amdgcn_update_dpp(x, x, 0x124, 0xF, 0xF, true));
    x = __builtin_bit_cast(int, v); v += __builtin_bit_cast(float, __builtin_amdgcn_update_dpp(x, x, 0x4E, 0xF, 0xF, true));
    x = __builtin_bit_cast(int, v); v += __builtin_bit_cast(float, __builtin_amdgcn_update_dpp(x, x, 0xB1, 0xF, 0xF, true));
    return v; }
__device__ __forceinline__ float sum32(float v) { auto rr = __builtin_amdgcn_permlane32_swap(__float_as_uint(v), __float_as_uint(v), false, false); return __uint_as_float(rr[0]) + __uint_as_float(rr[1]); }
__device__ __forceinline__ float wave_sum(float v) { v += shx<1>(v); v += shx<2>(v); v += shx<4>(v); v += shx<8>(v); v += shx<16>(v); return sum32(v); }
__device__ __forceinline__ float frcp(float x) { return __builtin_amdgcn_rcpf(x); }
__device__ __forceinline__ float frsq(float x) { return __builtin_amdgcn_rsqf(x); }
__device__ __forceinline__ float silu_f(float x) { return x * frcp(1.f + __expf(-x)); }

#ifndef REP_P0
#define REP_P0 1
#endif
#ifndef REP_P1
#define REP_P1 1
#endif
#ifndef REP_CONV
#define REP_CONV 1
#endif
#ifndef REP_ATT
#define REP_ATT 1
#endif
#ifndef REP_SCAN
#define REP_SCAN 1
#endif
#ifndef REP_P3
#define REP_P3 1
#endif
#ifndef PG8_SP2_ALL
#define PG8_SP2_ALL true
#endif
#ifndef PG8_ALIGN_P1
#define PG8_ALIGN_P1 true
#endif
struct Args { const float* in[15]; float* out; unsigned char* ws; };

struct Ctx {
    int tid, lane, wave, bid, G;
    const float *x, *norm_w, *w_in, *w_out, *lq1, *lk1, *lq2, *lk2, *subln_w, *rel_bias, *conv_w, *a_log, *dt_bias, *gdn_norm_w, *final_w;
    float* out; unsigned char* ws;
};

__device__ __forceinline__ int fresh_tid(int wave) { int l; asm volatile("v_mbcnt_lo_u32_b32 %0, -1, 0\n\tv_mbcnt_hi_u32_b32 %0, -1, %0" : "=v"(l)); return wave * 64 + l; }
__device__ __forceinline__ void relaunder(Ctx& F) { const int t = fresh_tid(F.wave); F.tid = t; F.lane = t & 63; }

__device__ __forceinline__ void p0_transpose_item(const float* W, int K, int N, const float* kscale, bf16_t* WT, int Nmain, bf16_t* WT2, LAS float* scr, int item, int lane) {
    const int nblk = (N + 63) / 64, kb = item / nblk, nb = item % nblk, k0 = 64 * kb, n0 = 64 * nb;
    const int nn = n0 + (lane & 15) * 4;
    f32x4 v[16];
#pragma unroll
    for (int i = 0; i < 16; ++i) { const int kk = 4 * i + (lane >> 4); v[i] = (nn < N) ? *(const f32x4*)(W + (size_t)(k0 + kk) * N + nn) : (f32x4){0.f, 0.f, 0.f, 0.f}; }
#pragma unroll
    for (int i = 0; i < 16; ++i) { const int kk = 4 * i + (lane >> 4); const float ks = kscale ? kscale[k0 + kk] : 1.f; LAS float* d = scr + kk * 65 + (lane & 15) * 4;
        d[0] = v[i][0] * ks; d[1] = v[i][1] * ks; d[2] = v[i][2] * ks; d[3] = v[i][3] * ks; }
    asm volatile("s_waitcnt lgkmcnt(0)" ::: "memory");
    const int c = lane & 7;
#pragma unroll
    for (int j = 0; j < 8; ++j) { const int n = (lane >> 3) + 8 * j; const LAS float* s = scr + (8 * c) * 65 + n;
        u32x4 o; o.x = cvtpk(s[0 * 65], s[1 * 65]); o.y = cvtpk(s[2 * 65], s[3 * 65]); o.z = cvtpk(s[4 * 65], s[5 * 65]); o.w = cvtpk(s[6 * 65], s[7 * 65]);
        const int ng = n0 + n;
        if (ng < Nmain) *(u32x4*)(WT + (((size_t)(ng >> 6) * (K / 32) + ((k0 + 8 * c) >> 5)) * 2048 + (ng & 63) * 32 + ((k0 + 8 * c) & 31))) = o;
        else if (ng < N) *(u32x4*)(WT2 + (size_t)(ng - Nmain) * K + k0 + 8 * c) = o; }
    asm volatile("s_waitcnt lgkmcnt(0)" ::: "memory");
}
constexpr int P0_I_IN = (DM / 64) * ((IN_COLS + 63) / 64), P0_I_OUT = (DM / 64) * (DM / 64), P0_LAYER_ITEMS = P0_I_IN + P0_I_OUT;
__device__ __forceinline__ void p0_weight_item(Ctx& F, LAS float* scr, int l, int r) {
    if (r < P0_I_IN) p0_transpose_item(F.w_in + (size_t)l * DM * IN_COLS, DM, IN_COLS, F.norm_w + l * DM, (bf16_t*)(F.ws + WS_WIN) + (size_t)l * NPROJ * DM, NPROJ,
                                       (bf16_t*)(F.ws + WS_WBA) + (size_t)l * 16 * DM, scr, r, F.lane);
    else p0_transpose_item(F.w_out + (size_t)l * DM * DM, DM, DM, nullptr, (bf16_t*)(F.ws + WS_WOUT) + (size_t)l * DM * DM, DM, nullptr, scr, r - P0_I_IN, F.lane);
}
__device__ __forceinline__ void p0_prologue(Ctx& F, LAS unsigned char* lds) {
    LAS float* scr = (LAS float*)(lds + F.wave * 17408);
    const int gw = F.bid * 8 + F.wave, NGW = F.G * 8;
    for (int it = gw; it < P0_LAYER_ITEMS; it += NGW) p0_weight_item(F, scr, 0, it);
    bf16_t* XB = (bf16_t*)(F.ws + WS_XB); float* RQ = (float*)(F.ws + WS_ROWSQ);
    for (int m = gw; m < M; m += NGW) {
        const f32x4* xr = (const f32x4*)(F.x + (size_t)m * DM) + F.lane; float ss = 0.f;
        bf16_t* xbrow = XB + pj2((size_t)m, 4 * F.lane);
        f32x4 xv8[8];
#pragma unroll
        for (int j = 0; j < 8; ++j) xv8[j] = xr[64 * j];
#pragma unroll
        for (int j = 0; j < 8; ++j) { const f32x4 v = xv8[j]; ss += (v[0] * v[0] + v[1] * v[1]) + (v[2] * v[2] + v[3] * v[3]); u32x2 w; w.x = cvtpk(v[0], v[1]); w.y = cvtpk(v[2], v[3]); *(u32x2*)(xbrow + (size_t)j * 8 * 2048) = w; }
        ss = wave_sum(ss);
        if (F.lane < 32) RQ[(size_t)m * 32 + F.lane] = (F.lane == 0) ? ss : 0.f;
    }
}

__device__ __forceinline__ void rstd_table(Ctx& F, LAS float* tab, int row0, int nrows) {
    const float* RQ = (const float*)(F.ws + WS_ROWSQ);
    const int r = F.tid >> 1, hf = F.tid & 1;
    float s = 0.f;
    if (r < nrows) { const f32x4* p = (const f32x4*)(RQ + (size_t)(row0 + r) * 32 + hf * 16);
#pragma unroll
        for (int i = 0; i < 4; ++i) { const f32x4 v = p[i]; s += (v[0] + v[1]) + (v[2] + v[3]); } }
    s += shx<1>(s);
    if (r < nrows && hf == 0) tab[r] = frsq(s * (1.0f / DM) + RMS_EPS);
}

__device__ __forceinline__ void ba_job(Ctx& F, LAS unsigned char* lds, int layer) {
    const bf16_t* XB = (const bf16_t*)(F.ws + WS_XB); const bf16_t* WB = (const bf16_t*)(F.ws + WS_WBA) + (size_t)layer * 16 * DM;
    float* BA = (float*)(F.ws + WS_BA);
    const int row0 = F.bid * 64; if (row0 >= M) return;
    LAS float* rs = (LAS float*)(lds + 65536);
    const int fr = F.lane & 15, fq = F.lane >> 4, k0 = F.wave * 256;
    bf16x8 bfr[8], afr[8][4];
#pragma unroll
    for (int s = 0; s < 8; ++s) { const int k = k0 + s * 32 + fq * 8;
        bfr[s] = *(const bf16x8*)(WB + (size_t)fr * DM + k);
#pragma unroll
        for (int rb = 0; rb < 4; ++rb) afr[s][rb] = *(const bf16x8*)(XB + pj2((size_t)(row0 + rb * 16 + fr), k)); }
    asm volatile("" ::: "memory");
    rstd_table(F, rs, row0, 64);
    f32x4 acc[4] = {};
#pragma unroll
    for (int s = 0; s < 8; ++s)
#pragma unroll
        for (int rb = 0; rb < 4; ++rb) acc[rb] = __builtin_amdgcn_mfma_f32_16x16x32_bf16(afr[s][rb], bfr[s], acc[rb], 0, 0, 0);
    LAS float* red = (LAS float*)lds + F.wave * 1024;
#pragma unroll
    for (int rb = 0; rb < 4; ++rb)
#pragma unroll
        for (int i = 0; i < 4; ++i) red[(rb * 16 + fq * 4 + i) * 16 + fr] = acc[rb][i];
    __syncthreads();
    for (int e = F.tid; e < 1024; e += 512) { float s = 0.f;
#pragma unroll
        for (int w = 0; w < 8; ++w) s += ((LAS float*)lds)[w * 1024 + e];
        BA[(size_t)row0 * 16 + e] = s * rs[e >> 4]; }
    __syncthreads();
}

namespace att {
constexpr int QB = 256, KVBLK = 64;
constexpr int SHM_V = 16384, SHM_K = 16384;
constexpr int OFF_V = 0, OFF_K = SHM_V, BUF2 = SHM_V + SHM_K, OFF_Q = 2 * BUF2;
constexpr int OFF_TAB = LDSX_OFF + 4096, OFF_WS = LDSX_OFF + 4096 + 2048;
constexpr int OFF_V2 = LDSX_OFF + 8192;
constexpr float SM_THR = 6.0f;
constexpr int NMAXT = 255;
#define KSWZ(row, colB) ((row) * 256 + ((colB) ^ (((row) & 7) << 4)))
#define SBAR() __builtin_amdgcn_sched_barrier(0)
__device__ __forceinline__ int v_st(int k, int c) { const int kk = (k & ~0xC) | ((k & 4) << 1) | ((k & 8) >> 1); return ((kk >> 3) * 4 + (c >> 5)) * 512 + ((kk & 7) * 32 + (c & 31)) * 2; }
__device__ __forceinline__ int v_rd_base(int lane) { return ((lane & 3) << 3) | (((lane >> 2) & 3) << 6) | (((lane >> 4) & 1) << 5) | (((lane >> 5) & 1) << 8); }
constexpr int v_rd_off(int d0, int ks, int half) { return d0 * 512 + ks * 4096 + half * 2048; }
__device__ __forceinline__ int crow(int r, int hi) { return (r & 3) + 8 * (r >> 2) + 4 * hi; }

__constant__ const unsigned char T5_BUCKET[113] = {0, 1, 2, 3, 4, 5, 6, 7, 8, 9, 10, 11, 12, 13, 14, 15, 16, 16, 16, 17, 17, 18, 18, 18, 19, 19, 19, 20, 20, 20, 20, 21, 21, 21, 21, 22, 22, 22, 22, 22, 23, 23, 23, 23, 23, 23,
    24, 24, 24, 24, 24, 24, 25, 25, 25, 25, 25, 25, 25, 26, 26, 26, 26, 26, 26, 26, 26, 27, 27, 27, 27, 27, 27, 27, 27, 27, 27, 28, 28, 28, 28, 28, 28, 28, 28, 28, 28, 29, 29, 29, 29, 29, 29, 29, 29, 29, 29, 29, 29,
    30, 30, 30, 30, 30, 30, 30, 30, 30, 30, 30, 30, 30, 30};

template <int KOFF> __device__ __forceinline__ void qkt(f32x16& p0, f32x16& p1, const unsigned* ka, const unsigned* qa, int mp) {
    p0 = f32x16{}; p1 = f32x16{};
#pragma unroll
    for (int dd = 0; dd < 4; ++dd) {
        const LAS char* a = (const LAS char*)(uintptr_t)ka[dd] + mp * 128 + KOFF; const LAS char* q = (const LAS char*)(uintptr_t)qa[dd] + mp * 128;
        const bf16x8 b0 = *reinterpret_cast<const LAS bf16x8*>(a);
        const bf16x8 b1 = *reinterpret_cast<const LAS bf16x8*>(a + 32 * 256);
        const bf16x8 qf = *reinterpret_cast<const LAS bf16x8*>(q);
        p0 = __builtin_amdgcn_mfma_f32_32x32x16_bf16(b0, qf, p0, 0, 0, 0);
        p1 = __builtin_amdgcn_mfma_f32_32x32x16_bf16(b1, qf, p1, 0, 0, 0); }
}
template <int VOFF> __device__ __forceinline__ void pv_tile(f32x16* o, int vb0, bf16x8 pa0, bf16x8 pa1, bf16x8 pa2, bf16x8 pa3) {
#define TRRD(dst, off) asm volatile("ds_read_b64_tr_b16 %0, %1 offset:%2" : "=&v"(dst) : "v"(vb0), "i"(off) : "memory")
#define PV_D0(d0) do { s16x4 l0, l1, l2, l3, h0, h1, h2, h3; constexpr int b_ = VOFF + v_rd_off(d0, 0, 0); \
        TRRD(l0, b_); TRRD(h0, b_ + 2048); TRRD(l1, b_ + 4096); TRRD(h1, b_ + 6144); TRRD(l2, b_ + 8192); TRRD(h2, b_ + 10240); TRRD(l3, b_ + 12288); TRRD(h3, b_ + 14336); \
        asm volatile("s_waitcnt lgkmcnt(0)" ::: "memory"); SBAR(); \
        o[d0] = __builtin_amdgcn_mfma_f32_32x32x16_bf16(pa0, (bf16x8){l0[0], l0[1], l0[2], l0[3], h0[0], h0[1], h0[2], h0[3]}, o[d0], 0, 0, 0); \
        o[d0] = __builtin_amdgcn_mfma_f32_32x32x16_bf16(pa1, (bf16x8){l1[0], l1[1], l1[2], l1[3], h1[0], h1[1], h1[2], h1[3]}, o[d0], 0, 0, 0); \
        o[d0] = __builtin_amdgcn_mfma_f32_32x32x16_bf16(pa2, (bf16x8){l2[0], l2[1], l2[2], l2[3], h2[0], h2[1], h2[2], h2[3]}, o[d0], 0, 0, 0); \
        o[d0] = __builtin_amdgcn_mfma_f32_32x32x16_bf16(pa3, (bf16x8){l3[0], l3[1], l3[2], l3[3], h3[0], h3[1], h3[2], h3[3]}, o[d0], 0, 0, 0); } while (0)
    PV_D0(0); PV_D0(1); PV_D0(2); PV_D0(3);
#undef PV_D0
#undef TRRD
}
__device__ __forceinline__ void softmax_tile(f32x16& p0, f32x16& p1, float& m_reg, float& l_reg, f32x16* o, float* al_l, int r32, int hi,
                                             bf16x8& pa0, bf16x8& pa1, bf16x8& pa2, bf16x8& pa3) {
    float pmax = p0[0];
#pragma unroll
    for (int r = 1; r < 16; ++r) pmax = fmaxf(pmax, p0[r]);
#pragma unroll
    for (int r = 0; r < 16; ++r) pmax = fmaxf(pmax, p1[r]);
    { auto rr = __builtin_amdgcn_permlane32_swap(__float_as_uint(pmax), __float_as_uint(pmax), false, false);
      pmax = fmaxf(__uint_as_float(rr[0]), __uint_as_float(rr[1])); }
    const float mn = fmaxf(m_reg, pmax);
    if (__any(pmax > m_reg + SM_THR)) {
        const float alpha = __builtin_amdgcn_exp2f(m_reg - mn);
        l_reg *= alpha; m_reg = mn;
        if (hi == 0) al_l[r32] = alpha;
        asm volatile("s_waitcnt lgkmcnt(0)" ::: "memory");
#pragma unroll
        for (int d_ = 0; d_ < 4; ++d_)
#pragma unroll
            for (int r = 0; r < 16; ++r) o[d_][r] *= al_l[crow(r, hi)];
    }
#pragma unroll
    for (int r = 0; r < 16; ++r) { p0[r] = __builtin_amdgcn_exp2f(p0[r] - m_reg); p1[r] = __builtin_amdgcn_exp2f(p1[r] - m_reg); }
    float ps = 0.f;
#pragma unroll
    for (int r = 0; r < 16; ++r) ps += p0[r];
#pragma unroll
    for (int r = 0; r < 16; ++r) ps += p1[r];
    { auto rr = __builtin_amdgcn_permlane32_swap(__float_as_uint(ps), __float_as_uint(ps), false, false);
      ps = __uint_as_float(rr[0]) + __uint_as_float(rr[1]); }
    l_reg += ps;
#define PK4(P, B_, OUT) do { unsigned a0 = cvtpk(P[B_+0], P[B_+1]), a1 = cvtpk(P[B_+2], P[B_+3]); \
        unsigned b0 = cvtpk(P[B_+4], P[B_+5]), b1 = cvtpk(P[B_+6], P[B_+7]); \
        auto r0 = __builtin_amdgcn_permlane32_swap(a0, b0, false, false); auto r1 = __builtin_amdgcn_permlane32_swap(a1, b1, false, false); \
        u32x4 w = {r0[0], r1[0], r0[1], r1[1]}; OUT = *reinterpret_cast<bf16x8*>(&w); } while (0)
    PK4(p0, 0, pa0); PK4(p0, 8, pa1); PK4(p1, 0, pa2); PK4(p1, 8, pa3);
#undef PK4
}

template <bool ISY> __device__ __forceinline__ void attn_unit(Ctx& F, char* lds, int layer, int b, int h, int qb, float lam, float one_minus_li, unsigned* wqp, volatile LAS unsigned* wqlp) {
    const int tid_ = fresh_tid(F.wave);
    const int tid = tid_, wid = F.wave, lane = tid & 63, r32 = lane & 31, hi = lane >> 5;
    const bf16_t* PROJ = (const bf16_t*)(F.ws + WS_PROJ); bf16_t* MIXED = (bf16_t*)(F.ws + WS_MIXED);
    const long rowbase = (long)b * SEQ; const int q0 = qb * QB;
    char* V_lds = lds + OFF_V; char* K_lds = lds + OFF_K;
    float* tab = (float*)(lds + OFF_TAB); float* al_l = (float*)(lds + OFF_WS) + wid * 64;
    char* Qw_lds = lds + OFF_Q + wid * 8192;
    const int sr = tid >> 4, sc = (tid & 15) * 8;
    const bf16_t* Kg = PROJ + pj((size_t)rowbase + sr, C_DAK + h * 128 + sc);
    const bf16_t* Vg = PROJ + pj((size_t)rowbase + sr, C_DAV + h * 128 + sc);
    bf16x8 st_k0, st_k1, st_v0, st_v1;
    { const int nb_ = NMAXT - tid;
      const float b31 = F.rel_bias[31 * NH + h];
      const float bv_ = (nb_ >= 0 && nb_ < 113) ? F.rel_bias[(int)T5_BUCKET[nb_] * NH + h] : b31;
      bf16x8 qv_[8];
      const size_t qrow0 = (size_t)(rowbase + q0 + wid * 32);
#pragma unroll
      for (int i = 0; i < 8; ++i) { const int e = i * 64 + lane, row = e >> 4, c8 = (e & 15) * 8; qv_[i] = *reinterpret_cast<const bf16x8*>(PROJ + pj(qrow0 + row, C_DAQ + h * 128 + c8)); }
      st_k0 = *(const bf16x8*)(Kg); st_k1 = *(const bf16x8*)(Kg + (size_t)1024); st_v0 = *(const bf16x8*)(Vg); st_v1 = *(const bf16x8*)(Vg + (size_t)1024);
      asm volatile("" ::: "memory");
      tab[tid] = (nb_ < 0) ? -__builtin_inff() : (bv_ - b31) * LOG2E;
#pragma unroll
      for (int i = 0; i < 8; ++i) { const int e = i * 64 + lane, row = e >> 4, c8 = (e & 15) * 8; *(bf16x8*)(Qw_lds + KSWZ(row, c8 * 2)) = qv_[i]; } }
    const int vst0 = v_st(sr, sc), vst1 = v_st(32 + sr, sc), kws = KSWZ(sr, sc * 2);
    const int vb0 = (int)(uintptr_t)V_lds + v_rd_base(lane);
    unsigned ka[4], qa[4];
#pragma unroll
    for (int dd = 0; dd < 4; ++dd) { const unsigned o_ = (unsigned)KSWZ(r32, (dd * 16 + hi * 8) * 2); ka[dd] = (unsigned)(uintptr_t)K_lds + o_; qa[dd] = (unsigned)(uintptr_t)Qw_lds + o_; }
    const int NT = (q0 + QB) / KVBLK;
    const int qlo = q0 + wid * 32;
    float m1 = -1e30f, l1 = 0.f, m2 = -1e30f, l2 = 0.f;
    f32x16 o1[4] = {}, o2[4] = {};
#define SLOAD(t) do { const size_t o_ = (size_t)(t) * PJ_RB; st_k0 = *(const bf16x8*)(Kg + o_); st_k1 = *(const bf16x8*)(Kg + o_ + (size_t)1024); \
                      st_v0 = *(const bf16x8*)(Vg + o_); st_v1 = *(const bf16x8*)(Vg + o_ + (size_t)1024); } while (0)
#define SWRITE(BO, VO) do { *(bf16x8*)(K_lds + (BO) + kws) = st_k0; *(bf16x8*)(K_lds + (BO) + kws + 32 * 256) = st_k1; *(bf16x8*)(lds + (VO) + vst0) = st_v0; *(bf16x8*)(lds + (VO) + vst1) = st_v1; } while (0)
    constexpr bool isY = ISY;
    bool pend = false;
    int vo_prev = OFF_V2, vo_cur = 0, vo_nxt = BUF2;
    bf16x8 pp0, pp1, pp2, pp3;
    f32x16 sy0, sy1;
#define ASTEP(t, CUR, NXT) do { \
        if ((t) + 1 < NT) { SWRITE((NXT) * BUF2, vo_nxt); } \
        if ((t) + 2 < NT) { SLOAD((t) + 2); } \
        if (isY && pend) { asm volatile("" ::: "memory"); softmax_tile(sy0, sy1, m2, l2, o2, al_l, r32, hi, pp0, pp1, pp2, pp3); SBAR(); pv_tile<0>(o2, vb0 + vo_prev, pp0, pp1, pp2, pp3); pend = false; SBAR(); } \
        const int kb = (t) * KVBLK; \
        if (kb <= qlo + 31) {                                \
        const bool band = (qlo - kb - 63) < 113;             \
        const int jb = NMAXT - (qlo + r32 - kb) + 4 * hi;    \
        { f32x16 p0, p1, s0, s1; bf16x8 pa0, pa1, pa2, pa3; \
            asm volatile("" ::: "memory"); \
            qkt<(CUR) * BUF2>(p0, p1, ka, qa, 0); \
            asm volatile("" ::: "memory"); \
            if (band) { _Pragma("unroll") for (int r = 0; r < 16; ++r) { const int c = (r & 3) + 8 * (r >> 2); p0[r] += tab[jb + c]; p1[r] += tab[jb + 32 + c]; } } \
            asm volatile("" ::: "memory"); \
            softmax_tile(p0, p1, m1, l1, o1, al_l, r32, hi, pa0, pa1, pa2, pa3); SBAR(); \
            qkt<(CUR) * BUF2>(s0, s1, ka, qa, 1); SBAR(); \
            pv_tile<0>(o1, vb0 + vo_cur, pa0, pa1, pa2, pa3); SBAR(); \
            if (band) { _Pragma("unroll") for (int r = 0; r < 16; ++r) { const int c = (r & 3) + 8 * (r >> 2); s0[r] += tab[jb + c]; s1[r] += tab[jb + 32 + c]; } } \
            asm volatile("" ::: "memory"); \
            if (isY) { sy0 = s0; sy1 = s1; pend = true; } \
            else { softmax_tile(s0, s1, m2, l2, o2, al_l, r32, hi, pp0, pp1, pp2, pp3); SBAR(); pv_tile<0>(o2, vb0 + vo_cur, pp0, pp1, pp2, pp3); } \
        } } \
        asm volatile("s_waitcnt lgkmcnt(0)" ::: "memory"); __builtin_amdgcn_s_barrier(); asm volatile("" ::: "memory");        \
        { const int tmp_ = vo_prev; vo_prev = vo_cur; vo_cur = vo_nxt; vo_nxt = tmp_; } } while (0)
    SWRITE(0, 0); SLOAD(1);
    __syncthreads();
#pragma unroll 1
    for (int t = 0; t < NT; t += 2) { ASTEP(t, 0, 1); ASTEP(t + 1, 1, 0); }
    if (isY && pend) { asm volatile("" ::: "memory"); softmax_tile(sy0, sy1, m2, l2, o2, al_l, r32, hi, pp0, pp1, pp2, pp3); SBAR(); pv_tile<0>(o2, vb0 + vo_prev, pp0, pp1, pp2, pp3); }
#undef SLOAD
#undef SWRITE
#undef ASTEP
    __syncthreads();
    unsigned nxt_ = 0u; if (tid == 0) nxt_ = __hip_atomic_fetch_add(wqp, 1u, __ATOMIC_RELAXED, __HIP_MEMORY_SCOPE_AGENT);
    { float* stg = (float*)(lds + wid * 16384);
      const int row = lane >> 1, hf = lane & 1;
      const size_t grow = (size_t)(rowbase + q0 + wid * 32 + row);
      const bf16_t* gp = PROJ + pj(grow, C_DAG + h * 128 + hf * 64);
      u32x4 g8[8];
#pragma unroll
      for (int i = 0; i < 8; ++i) g8[i] = *(const u32x4*)(gp + (i >> 2) * 2048 + (i & 3) * 8);
      asm volatile("" ::: "memory");
      if (hi == 0) { al_l[r32] = frcp(l1); al_l[32 + r32] = lam * frcp(l2); }
      asm volatile("s_waitcnt lgkmcnt(0)" ::: "memory");
#pragma unroll
      for (int r = 0; r < 16; ++r) { const int orow = crow(r, hi); const float a = al_l[orow], bb = al_l[32 + orow];
#pragma unroll
          for (int d0 = 0; d0 < 4; ++d0) stg[orow * 128 + d0 * 32 + r32] = o1[d0][r] * a - o2[d0][r] * bb; }
      asm volatile("s_waitcnt lgkmcnt(0)" ::: "memory");
      const f32x4* sp = (const f32x4*)(stg + row * 128 + hf * 64);
      float ss = 0.f;
#pragma unroll
      for (int i = 0; i < 16; ++i) { const f32x4 t4 = sp[i]; ss += (t4[0] * t4[0] + t4[1] * t4[1]) + (t4[2] * t4[2] + t4[3] * t4[3]); }
      ss += shx<1>(ss);
      const float rs = one_minus_li * frsq(ss * (1.0f / 128.0f) + RMS_EPS);
      bf16_t* op = MIXED + pj2(grow, h * 128 + hf * 64);
      const float* sw = F.subln_w + layer * 128 + hf * 64;
#pragma unroll 2
      for (int i = 0; i < 8; ++i) { const u32x4 g = g8[i]; const f32x4 w0 = *(const f32x4*)(sw + i * 8), w1 = *(const f32x4*)(sw + i * 8 + 4);
          const f32x4 a = sp[2 * i], c = sp[2 * i + 1]; u32x4 o;
          o.x = cvtpk(a[0] * rs * w0[0] * bf_lo(g.x), a[1] * rs * w0[1] * bf_hi(g.x));
          o.y = cvtpk(a[2] * rs * w0[2] * bf_lo(g.y), a[3] * rs * w0[3] * bf_hi(g.y));
          o.z = cvtpk(c[0] * rs * w1[0] * bf_lo(g.z), c[1] * rs * w1[1] * bf_hi(g.z));
          o.w = cvtpk(c[2] * rs * w1[2] * bf_lo(g.w), c[3] * rs * w1[3] * bf_hi(g.w));
          *(u32x4*)(op + (i >> 2) * 2048 + (i & 3) * 8) = o; }
    }
    if (tid == 0) wqlp[0] = nxt_;
    __syncthreads();
}

#undef SBAR
}

namespace gdn {
constexpr int WAVE_LDS = 18432;
constexpr int LT_PITCH = 144;
__host__ __device__ constexpr int ro4(int i) { return i == 0 ? 0 : 4 * ((((i - 1) / 4) + 1) * (2 * ((i - 1) / 4) + (i - 4 * ((i - 1) / 4)) - 1)); }
using att::v_st; using att::v_rd_base; using att::v_rd_off; using att::crow;

#define MKRS(p) __builtin_amdgcn_make_buffer_rsrc((void*)(p), 0, 0x02000000, 0x00020000)
typedef unsigned v4u_t __attribute__((__vector_size__(16)));
__device__ __forceinline__ u32x4 bld128(__amdgpu_buffer_rsrc_t r, unsigned vo, unsigned so) { return __builtin_bit_cast(u32x4, __builtin_amdgcn_raw_buffer_load_b128(r, vo, so, 0)); }
__device__ __forceinline__ void bst128(u32x4 v, __amdgpu_buffer_rsrc_t r, unsigned vo, unsigned so) { __builtin_amdgcn_raw_buffer_store_b128(__builtin_bit_cast(v4u_t, v), r, vo, so, 0); }
__device__ __forceinline__ bf16_t* wbuf(Ctx& F) { return (bf16_t*)((char*)F.out + 64 * MiB); }
__device__ __forceinline__ bf16_t* qkbuf(Ctx& F) { return (bf16_t*)((char*)F.out + 96 * MiB); }
__device__ __forceinline__ void chunk_prep(Ctx& F, char* wl, int layer, int item) {
    const int tid_ = fresh_tid(F.wave);
    const int lane = tid_ & 63, r32 = lane & 31, hi = lane >> 5;
    const int n = item & 63, bh = item >> 6, b = bh >> 3, h = bh & 7;
    const size_t m0 = (size_t)b * SEQ + (size_t)n * 64;
    bf16_t* QN = (bf16_t*)F.out; bf16_t* KN = (bf16_t*)((char*)F.out + 32 * MiB); bf16_t* VN = (bf16_t*)(F.ws + WS_VN);
    float* GB = (float*)(F.ws + WS_GB); const float* BA = (const float*)(F.ws + WS_BA); const bf16_t* PROJ = (const bf16_t*)(F.ws + WS_PROJ);
    const __amdgpu_buffer_rsrc_t rsQ = MKRS(QN + m0 * 1024 + h * 128), rsK = MKRS(KN + m0 * 1024 + h * 128), rsV = MKRS(VN + m0 * 1024 + h * 128);
    const unsigned offS = (unsigned)(((lane >> 4) * 1024 + (lane & 15) * 8) * 2);
    float* Lp = (float*)wl; char* Tl = wl; char* stg = wl + 9216; float* Gt = (float*)(wl + 17408); float* Bt = Gt + 64;
    const int g4 = lane >> 4, c8 = (lane & 15) * 8;
    const bool zero_hist = (n == 0) && (g4 == 0);
    const bf16_t* src0 = PROJ + pj(m0 + 16 * g4, C_GQ + h * 128 + c8);
    const bf16_t* hsrc0 = (g4 == 0) ? (src0 - PJ_RB + 64 * 32) : src0;
    const float* cw0 = F.conv_w + (size_t)layer * 4 * 3072 + h * 128 + c8;
    typedef float f32x2_t __attribute__((ext_vector_type(2)));
    u32x4 rawA[8], rawB[8], hal[3]; f32x2_t wA[4][4], wB[4][4];
#define UNPK(dstv, u) do { dstv[0] = (f32x2_t){bf_lo(u.x), bf_hi(u.x)}; dstv[1] = (f32x2_t){bf_lo(u.y), bf_hi(u.y)}; dstv[2] = (f32x2_t){bf_lo(u.z), bf_hi(u.z)}; dstv[3] = (f32x2_t){bf_lo(u.w), bf_hi(u.w)}; } while (0)
#define CLOAD(t, R, blk) do { _Pragma("unroll") for (int j_ = 0; j_ < 8; ++j_) R[j_] = *(const u32x4*)(src0 + (t) * 32 * 2048 + ((blk) * 8 + j_) * 32); } while (0)
#define CLOADH(t) do { hal[0] = *(const u32x4*)(hsrc0 + (t) * 32 * 2048 - 1 * 32); hal[1] = *(const u32x4*)(hsrc0 + (t) * 32 * 2048 - 2 * 32); hal[2] = *(const u32x4*)(hsrc0 + (t) * 32 * 2048 - 3 * 32); } while (0)
#define CLOADW(t, W) do { _Pragma("unroll") for (int j = 0; j < 4; ++j) { const f32x4 a = *(const f32x4*)(cw0 + j * 3072 + (t) * 1024), bb = *(const f32x4*)(cw0 + j * 3072 + (t) * 1024 + 4); \
          W[j][0] = (f32x2_t){a[0], a[1]}; W[j][1] = (f32x2_t){a[2], a[3]}; W[j][2] = (f32x2_t){bb[0], bb[1]}; W[j][3] = (f32x2_t){bb[2], bb[3]}; } } while (0)
#define CFENCE() asm volatile("" ::: "memory")
    CLOADH(0); CLOAD(0, rawA, 0); CLOAD(0, rawB, 1); CLOADW(0, wA);
    CFENCE();
    { const float braw = BA[(m0 + lane) * 16 + h], araw = BA[(m0 + lane) * 16 + 8 + h] + F.dt_bias[layer * NH + h];
      const float sp = fmaxf(araw, 0.f) + __logf(1.f + __expf(-fabsf(araw)));
      const float g = -__expf(F.a_log[layer * NH + h]) * sp, beta = frcp(1.f + __expf(-braw));
      Gt[lane] = g; asm volatile("s_waitcnt lgkmcnt(0)" ::: "memory");
      float Gc = 0.f;
#pragma unroll 8
      for (int m = 0; m < 64; ++m) { const float gm = Gt[m]; Gc += (m <= lane) ? gm : 0.f; }
      asm volatile("s_waitcnt lgkmcnt(0)" ::: "memory");
      Gt[lane] = Gc; Bt[lane] = beta; GB[(m0 + lane) * 16 + h] = Gc;
      asm volatile("s_waitcnt lgkmcnt(0)" ::: "memory"); }
    f32x2_t x1[4], x2[4], x3[4];
    {
#define CINIT() do { UNPK(x1, hal[0]); UNPK(x2, hal[1]); UNPK(x3, hal[2]); \
          _Pragma("unroll") for (int i = 0; i < 4; ++i) { x1[i] = zero_hist ? (f32x2_t){0.f, 0.f} : x1[i]; x2[i] = zero_hist ? (f32x2_t){0.f, 0.f} : x2[i]; x3[i] = zero_hist ? (f32x2_t){0.f, 0.f} : x3[i]; } } while (0)
#define CROWS(t, R, blk, W) do { bf16_t* dst_ = (((t) == 0) ? QN : ((t) == 1) ? KN : VN) + (m0 + 16 * g4 + (blk) * 8) * 1024 + h * 128 + c8; \
          _Pragma("unroll") for (int j_ = 0; j_ < 8; ++j_) { f32x2_t x0[4]; UNPK(x0, R[j_]); f32x2_t y[4]; f32x2_t ss2 = {0.f, 0.f}; \
          _Pragma("unroll") for (int i = 0; i < 4; ++i) { f32x2_t a = W[0][i] * x3[i]; a = __builtin_elementwise_fma(W[1][i], x2[i], a); a = __builtin_elementwise_fma(W[2][i], x1[i], a); a = __builtin_elementwise_fma(W[3][i], x0[i], a); \
              f32x2_t e = a * (f32x2_t){-LOG2E, -LOG2E}; e = (f32x2_t){__builtin_amdgcn_exp2f(e.x), __builtin_amdgcn_exp2f(e.y)} + (f32x2_t){1.f, 1.f}; \
              a = a * (f32x2_t){__builtin_amdgcn_rcpf(e.x), __builtin_amdgcn_rcpf(e.y)}; y[i] = a; ss2 = __builtin_elementwise_fma(a, a, ss2); x3[i] = x2[i]; x2[i] = x1[i]; x1[i] = x0[i]; } \
          float ss = rsum16(ss2.x + ss2.y); \
          const float sc_ = ((t) < 2) ? (((t) == 0) ? 0.08838834764831845f : 1.f) * frsq(ss + RMS_EPS) : 1.f; \
          const f32x2_t sc2 = {sc_, sc_}; const f32x2_t y0 = y[0] * sc2, y1 = y[1] * sc2, y2 = y[2] * sc2, y3 = y[3] * sc2; \
          u32x4 o; o.x = cvtpk(y0.x, y0.y); o.y = cvtpk(y1.x, y1.y); o.z = cvtpk(y2.x, y2.y); o.w = cvtpk(y3.x, y3.y); \
          *(u32x4*)(dst_ + (size_t)j_ * 1024) = o; } } while (0)
      CINIT();
      CROWS(0, rawA, 0, wA);
      CFENCE(); CLOADH(1); CLOADW(1, wB); CLOAD(1, rawA, 0); CFENCE();
      CROWS(0, rawB, 1, wA);
      CFENCE(); CLOAD(1, rawB, 1); CFENCE();
      CINIT();
      CROWS(1, rawA, 0, wB);
      CROWS(1, rawB, 1, wB);
      asm volatile("s_waitcnt vmcnt(0)" ::: "memory"); }
    bf16x8 kf[2][8], qf[2][8];
    { const bf16_t* kp = KN + (m0 + r32) * 1024 + h * 128 + hi * 8;
#pragma unroll
      for (int s = 0; s < 8; ++s) { kf[0][s] = *(const bf16x8*)(kp + s * 16); kf[1][s] = *(const bf16x8*)(kp + (size_t)32 * 1024 + s * 16); }
      const bf16_t* qp = QN + (m0 + r32) * 1024 + h * 128 + hi * 8;
#pragma unroll
      for (int s = 0; s < 8; ++s) { qf[0][s] = *(const bf16x8*)(qp + s * 16); qf[1][s] = *(const bf16x8*)(qp + (size_t)32 * 1024 + s * 16); } }
    const float Gj0 = Gt[r32], Gj1 = Gt[32 + r32];
    { f32x16 c00 = {}, c10 = {}, c11 = {};
#pragma unroll
      for (int s = 0; s < 8; ++s) { c00 = __builtin_amdgcn_mfma_f32_32x32x16_bf16(kf[0][s], kf[0][s], c00, 0, 0, 0);
          c10 = __builtin_amdgcn_mfma_f32_32x32x16_bf16(kf[1][s], kf[0][s], c10, 0, 0, 0); c11 = __builtin_amdgcn_mfma_f32_32x32x16_bf16(kf[1][s], kf[1][s], c11, 0, 0, 0); }
#pragma unroll
      for (int q = 0; q < 4; ++q) {
          const f32x4 gA = *(const f32x4*)(Gt + 8 * q + 4 * hi), bA = *(const f32x4*)(Bt + 8 * q + 4 * hi), gB = *(const f32x4*)(Gt + 32 + 8 * q + 4 * hi), bB = *(const f32x4*)(Bt + 32 + 8 * q + 4 * hi);
#pragma unroll
          for (int e = 0; e < 4; ++e) { const int r = 4 * q + e, il0 = 8 * q + e, il = il0 + 4 * hi;
              const int o0 = hi ? ro4(il0 + 4) : ro4(il0), o1 = hi ? ro4(32 + il0 + 4) : ro4(32 + il0);
              if (r32 < il) Lp[o0 + r32] = bA[e] * c00[r] * __expf(gA[e] - Gj0);
              Lp[o1 + r32] = bB[e] * c10[r] * __expf(gB[e] - Gj0);
              if (r32 < il) Lp[o1 + 32 + r32] = bB[e] * c11[r] * __expf(gB[e] - Gj1); } } }
    { f32x16 d00 = {}, d10 = {}, d11 = {};
#pragma unroll
      for (int s = 0; s < 8; ++s) { const bf16x8 q0 = qf[0][s], q1 = qf[1][s];
          d00 = __builtin_amdgcn_mfma_f32_32x32x16_bf16(q0, kf[0][s], d00, 0, 0, 0);
          d10 = __builtin_amdgcn_mfma_f32_32x32x16_bf16(q1, kf[0][s], d10, 0, 0, 0); d11 = __builtin_amdgcn_mfma_f32_32x32x16_bf16(q1, kf[1][s], d11, 0, 0, 0); }
      bf16_t* qs_ = (bf16_t*)stg;
#pragma unroll
      for (int q = 0; q < 4; ++q) {
          const f32x4 gA = *(const f32x4*)(Gt + 8 * q + 4 * hi), gB = *(const f32x4*)(Gt + 32 + 8 * q + 4 * hi);
#pragma unroll
          for (int e = 0; e < 4; ++e) { const int r = 4 * q + e, il = 8 * q + e + 4 * hi;
          const float v00 = (r32 <= il) ? d00[r] * __expf(gA[e] - Gj0) : 0.f;
          const float v10 = d10[r] * __expf(gB[e] - Gj0);
          const float v11 = (r32 <= il) ? d11[r] * __expf(gB[e] - Gj1) : 0.f;
          qs_[il * 64 + r32] = (bf16_t)(cvtpk(v00, 0.f) & 0xffffu); qs_[il * 64 + 32 + r32] = (bf16_t)0;
          qs_[(32 + il) * 64 + r32] = (bf16_t)(cvtpk(v10, 0.f) & 0xffffu); qs_[(32 + il) * 64 + 32 + r32] = (bf16_t)(cvtpk(v11, 0.f) & 0xffffu); } }
      asm volatile("s_waitcnt lgkmcnt(0)" ::: "memory");
      const __amdgpu_buffer_rsrc_t rsQK = MKRS(qkbuf(F) + m0 * 512 + h * 64);
      const unsigned offQ = (unsigned)(((lane >> 3) * 512 + (lane & 7) * 8) * 2);
#pragma unroll
      for (int i = 0; i < 8; ++i) { const int e = i * 64 + lane, row = e >> 3, c = e & 7; bst128(*(const u32x4*)(stg + row * 128 + c * 16), rsQK, offQ, i * 8 * 512 * 2); } }
    asm volatile("s_waitcnt lgkmcnt(0)" ::: "memory");
    CLOADH(2); CLOADW(2, wA); CLOAD(2, rawA, 0); CLOAD(2, rawB, 1);
    CFENCE();
    float T[64];
    {
    constexpr int NCH = 528;
    f32x4 ring[8];
#pragma unroll
    for (int c = 0; c < 8; ++c) ring[c] = *(const f32x4*)(Lp + 4 * c);
    asm volatile("" ::: "memory");
    T[0] = (lane == 0) ? 1.f : 0.f;
#pragma unroll
    for (int i = 1; i < 64; ++i) { float acc = (lane == i) ? 1.f : 0.f;
#pragma unroll
        for (int q4 = 0; q4 < (i + 3) / 4; ++q4) { const int c = ro4(i) / 4 + q4; const f32x4 l4 = ring[c & 7];
#pragma unroll
            for (int e = 0; e < 4; ++e) if (4 * q4 + e < i) acc -= l4[e] * T[4 * q4 + e];
            if (c + 8 < NCH) { ring[c & 7] = *(const f32x4*)(Lp + 4 * (c + 8)); asm volatile("" ::: "memory"); } }
        T[i] = acc; }
    asm volatile("" : "+v"(T[63]) :: "memory"); }
    asm volatile("s_waitcnt lgkmcnt(0)" ::: "memory");
    const int vb0 = (int)(uintptr_t)stg + v_rd_base(lane);
    const float betac = Bt[lane], gcc = Gt[lane];
#pragma unroll
    for (int i = 0; i < 64; ++i) *(bf16_t*)(Tl + i * LT_PITCH + lane * 2) = (bf16_t)(cvtpk(T[i] * betac, 0.f) & 0xffffu);
    u32x4 vout[16];
#define CROWSV(R, blk, W) do { _Pragma("unroll") for (int j_ = 0; j_ < 8; ++j_) { f32x2_t x0[4]; UNPK(x0, R[j_]); f32x2_t y[4]; \
          _Pragma("unroll") for (int i = 0; i < 4; ++i) { f32x2_t a = W[0][i] * x3[i]; a = __builtin_elementwise_fma(W[1][i], x2[i], a); a = __builtin_elementwise_fma(W[2][i], x1[i], a); a = __builtin_elementwise_fma(W[3][i], x0[i], a); \
              f32x2_t e = a * (f32x2_t){-LOG2E, -LOG2E}; e = (f32x2_t){__builtin_amdgcn_exp2f(e.x), __builtin_amdgcn_exp2f(e.y)} + (f32x2_t){1.f, 1.f}; \
              a = a * (f32x2_t){__builtin_amdgcn_rcpf(e.x), __builtin_amdgcn_rcpf(e.y)}; y[i] = a; x3[i] = x2[i]; x2[i] = x1[i]; x1[i] = x0[i]; } \
          u32x4 o; o.x = cvtpk(y[0].x, y[0].y); o.y = cvtpk(y[1].x, y[1].y); o.z = cvtpk(y[2].x, y[2].y); o.w = cvtpk(y[3].x, y[3].y); vout[(blk) * 8 + j_] = o; } } while (0)
    CINIT();
    CROWSV(rawA, 0, wA);
    CROWSV(rawB, 1, wA);
#undef CROWSV
#undef CLOAD
#undef CLOADH
#undef CLOADW
#undef CINIT
#undef CROWS
#undef CFENCE
#undef UNPK
#pragma unroll
    for (int pass = 0; pass < 2; ++pass) {
        const float egc = __expf(gcc);
        const __amdgpu_buffer_rsrc_t rsX = MKRS((pass == 0 ? VN : KN) + m0 * 1024 + h * 128);
        const __amdgpu_buffer_rsrc_t rsW = MKRS(wbuf(F) + m0 * 1024 + h * 128);
        const unsigned offU = (unsigned)(((lane >> 3) * 1024 + ((lane >> 2) & 1) * 64 + (lane & 3) * 8) * 2);
        if (pass == 1) {
#pragma unroll
            for (int i = 0; i < 64; ++i) { bf16_t* tp = (bf16_t*)(Tl + i * LT_PITCH + lane * 2); *tp = (bf16_t)(cvtpk(__uint_as_float((unsigned)*tp << 16) * egc, 0.f) & 0xffffu); } }
        f32x16 acc0[4], acc1[4];
        bf16x8 xst[8];
#define STAGE_LOAD(hf) do { _Pragma("unroll") for (int i8 = 0; i8 < 8; ++i8) { xst[i8] = __builtin_bit_cast(bf16x8, bld128(rsX, offS, (32 * (hf) + 4 * i8) * 2048)); } } while (0)
#define STAGE_WRITE() do { _Pragma("unroll") for (int i8 = 0; i8 < 8; ++i8) { const int tok = 4 * i8 + (lane >> 4), c8 = (lane & 15) * 8; \
            *(bf16x8*)(stg + v_st(tok, c8)) = xst[i8]; } asm volatile("s_waitcnt lgkmcnt(0)" ::: "memory"); } while (0)
#define TRRD(dst, off) asm volatile("ds_read_b64_tr_b16 %0, %1 offset:%2" : "=&v"(dst) : "v"(vb0), "i"(off) : "memory")
#define MM_HALF(ACC, ib, kh) do { _Pragma("unroll") for (int d0 = 0; d0 < 4; ++d0) { s16x4 l0, h0, l1, h1; \
            if (d0 == 0) { TRRD(l0, 0); TRRD(h0, 2048); TRRD(l1, 4096); TRRD(h1, 6144); } else if (d0 == 1) { TRRD(l0, 512); TRRD(h0, 512 + 2048); TRRD(l1, 512 + 4096); TRRD(h1, 512 + 6144); } \
            else if (d0 == 2) { TRRD(l0, 1024); TRRD(h0, 1024 + 2048); TRRD(l1, 1024 + 4096); TRRD(h1, 1024 + 6144); } else { TRRD(l0, 1536); TRRD(h0, 1536 + 2048); TRRD(l1, 1536 + 4096); TRRD(h1, 1536 + 6144); } \
            const bf16x8 a0 = *(const bf16x8*)(Tl + (32 * (ib) + r32) * LT_PITCH + (16 * (2 * (kh)) + 8 * hi) * 2), a1 = *(const bf16x8*)(Tl + (32 * (ib) + r32) * LT_PITCH + (16 * (2 * (kh) + 1) + 8 * hi) * 2); \
            asm volatile("s_waitcnt lgkmcnt(0)" ::: "memory"); __builtin_amdgcn_sched_barrier(0); \
            ACC[d0] = __builtin_amdgcn_mfma_f32_32x32x16_bf16(a0, (bf16x8){l0[0], l0[1], l0[2], l0[3], h0[0], h0[1], h0[2], h0[3]}, ACC[d0], 0, 0, 0); \
            ACC[d0] = __builtin_amdgcn_mfma_f32_32x32x16_bf16(a1, (bf16x8){l1[0], l1[1], l1[2], l1[3], h1[0], h1[1], h1[2], h1[3]}, ACC[d0], 0, 0, 0); } } while (0)
#define STORE_OUT(ACC, ib) do { bf16_t* so_ = (bf16_t*)stg; _Pragma("unroll") for (int d0 = 0; d0 < 4; ++d0) _Pragma("unroll") for (int r = 0; r < 16; ++r) so_[crow(r, hi) * 128 + d0 * 32 + r32] = (bf16_t)(cvtpk(ACC[d0][r], 0.f) & 0xffffu); \
            asm volatile("s_waitcnt lgkmcnt(0)" ::: "memory"); \
            _Pragma("unroll") for (int i = 0; i < 8; ++i) { const int e = i * 64 + lane, row = e >> 4, c = e & 15; bst128(*(const u32x4*)(stg + row * 256 + c * 16), rsW, offS, (32 * (ib) + 4 * i) * 2048); } \
            asm volatile("s_waitcnt lgkmcnt(0)" ::: "memory"); } while (0)
#define STORE_UT(ACC, ib) do { _Pragma("unroll") for (int d0 = 0; d0 < 4; ++d0) _Pragma("unroll") for (int q_ = 0; q_ < 4; ++q_) { \
            u32x2 w_; w_.x = cvtpk(ACC[d0][4 * q_], ACC[d0][4 * q_ + 1]); w_.y = cvtpk(ACC[d0][4 * q_ + 2], ACC[d0][4 * q_ + 3]); \
            *(u32x2*)(stg + (d0 * 32 + r32) * 64 + (8 * q_ + 4 * hi) * 2) = w_; } \
            asm volatile("s_waitcnt lgkmcnt(0)" ::: "memory"); \
            _Pragma("unroll") for (int i = 0; i < 8; ++i) { const int e = i * 64 + lane, v_ = e >> 2, c = e & 3; \
                bst128(*(const u32x4*)(stg + v_ * 64 + c * 16), rsV, offU, (8 * i * 1024 + (ib) * 32) * 2); } \
            asm volatile("s_waitcnt lgkmcnt(0)" ::: "memory"); } while (0)
#define VWRITE(hf) do { if ((g4 >> 1) == (hf)) { _Pragma("unroll") for (int r_ = 0; r_ < 16; ++r_) *(u32x4*)(stg + v_st(16 * (g4 & 1) + r_, c8)) = vout[r_]; } asm volatile("s_waitcnt lgkmcnt(0)" ::: "memory"); } while (0)
        if (pass == 0) { VWRITE(0); } else { STAGE_LOAD(0); STAGE_WRITE(); }
        asm volatile("" ::: "memory");
#pragma unroll
        for (int d0 = 0; d0 < 4; ++d0) { acc0[d0] = f32x16{}; acc1[d0] = f32x16{}; }
        MM_HALF(acc0, 0, 0);
        MM_HALF(acc1, 1, 0);
        asm volatile("s_waitcnt lgkmcnt(0)" ::: "memory");
        if (pass == 1) { STORE_OUT(acc0, 0); STAGE_LOAD(1); STAGE_WRITE(); }
        else { VWRITE(1); }
        MM_HALF(acc1, 1, 1);
        asm volatile("s_waitcnt lgkmcnt(0)" ::: "memory");
        if (pass == 1) { STORE_OUT(acc1, 1); } else { STORE_UT(acc0, 0); STORE_UT(acc1, 1); }
#undef STORE_UT

#undef STAGE_LOAD
#undef STAGE_WRITE
#undef VWRITE
#undef TRRD
#undef MM_HALF
#undef STORE_OUT
    }
}

constexpr int S_WP = 272, S_QKP = 144, S_KP = 288, S_OP = 272;
constexpr int S_WL = 0, S_QL = 64 * S_WP, S_KL = 2 * 64 * S_WP, S_QKL = S_KL + 64 * S_KP, S_BUF = S_QKL + 64 * S_QKP;
constexpr int S_OT = 2 * S_BUF, S_OTSZ = 64 * S_OP, S_TAB = S_OT + 2 * S_OTSZ, S_TABSZ = 528, S_END = S_TAB + 2 * S_TABSZ;
static_assert(S_END <= LDS_BARST, "scan LDS map");
typedef unsigned long long u64_t;
__device__ __forceinline__ bf16x8 frag2(const char* p0, const char* p1) { const u64_t a = *(const u64_t*)p0, b = *(const u64_t*)p1; typedef u64_t u64x2 __attribute__((ext_vector_type(2))); const u64x2 w = {a, b}; return __builtin_bit_cast(bf16x8, w); }
__device__ __forceinline__ void scan_mfma(Ctx& F, char* lds, int layer, int bh) {
    const int tid_ = fresh_tid(F.wave);
    const int tid = tid_, lane = tid & 63, wave = F.wave, fr = lane & 15, g = lane >> 4;
    const bool is_compute = wave < 4;
    const int b = bh >> 3, h = bh & 7;
    const bf16_t* QN = (const bf16_t*)F.out; const bf16_t* KN = (const bf16_t*)((const char*)F.out + 32 * MiB); const bf16_t* UT = (const bf16_t*)(F.ws + WS_VN);
    const float* GB = (const float*)(F.ws + WS_GB); const bf16_t* PROJ = (const bf16_t*)(F.ws + WS_PROJ); bf16_t* MIXED = (bf16_t*)(F.ws + WS_MIXED);
    const size_t mb0 = (size_t)b * SEQ;
    const int vb = (wave & 3) * 32;
    f32x4 Sacc[2][8];
#pragma unroll
    for (int c = 0; c < 2; ++c)
#pragma unroll
        for (int d = 0; d < 8; ++d) Sacc[c][d] = (f32x4){0.f, 0.f, 0.f, 0.f};
    const __amdgpu_buffer_rsrc_t rsU = __builtin_amdgcn_make_buffer_rsrc((void*)UT, 0, 0x02000000, 0x00020000);
    unsigned offU[2];
#pragma unroll
    for (int c = 0; c < 2; ++c) { const int v = vb + 16 * c + fr; offU[c] = (unsigned)((((v >> 1) * 1024 + (v & 1) * 64) + 4 * g) * 2); }
    u32x2 uA[2][4], uB[2][4];
#define ULOAD(dst, nn) do { const unsigned so_ = (unsigned)(((mb0 + (size_t)(nn) * 64) * 1024 + h * 128) * 2); _Pragma("unroll") for (int c = 0; c < 2; ++c) _Pragma("unroll") for (int t = 0; t < 4; ++t) \
        dst[c][t] = __builtin_bit_cast(u32x2, __builtin_amdgcn_raw_buffer_load_b64(rsU, offU[c] + 32u * t, so_, 0)); } while (0)
    const int t2 = tid - 256;
    const int r0 = t2 >> 4, c0 = t2 & 15, rq = t2 >> 3, cq = t2 & 7;
    u32x4 pw[4], pq[4], pk[4], pqk[2]; float pg = 0.f, pgl = 0.f;
    const unsigned offN = (unsigned)((r0 * 1024 + c0 * 8) * 2), offQK = (unsigned)((rq * 512 + cq * 8) * 2);
#define SLOADC(nn) do { const char* wc_ = (const char*)(wbuf(F) + (mb0 + (size_t)(nn) * 64) * 1024 + h * 128); const char* qc_ = (const char*)(QN + (mb0 + (size_t)(nn) * 64) * 1024 + h * 128); \
        const char* kc_ = (const char*)(KN + (mb0 + (size_t)(nn) * 64) * 1024 + h * 128); const char* qkc_ = (const char*)(qkbuf(F) + (mb0 + (size_t)(nn) * 64) * 512 + h * 64); \
        _Pragma("unroll") for (int i = 0; i < 4; ++i) { pw[i] = *(const u32x4*)(wc_ + offN + (unsigned)(i * 16 * 1024 * 2)); pq[i] = *(const u32x4*)(qc_ + offN + (unsigned)(i * 16 * 1024 * 2)); pk[i] = *(const u32x4*)(kc_ + offN + (unsigned)(i * 16 * 1024 * 2)); } \
        pqk[0] = *(const u32x4*)(qkc_ + offQK); pqk[1] = *(const u32x4*)(qkc_ + offQK + 32u * 512u * 2u); \
        if (t2 < 64) { const char* gc_ = (const char*)(GB + (mb0 + (size_t)(nn) * 64) * 16 + h); pg = *(const float*)(gc_ + t2 * 64); pgl = *(const float*)(gc_ + 63 * 64); } } while (0)
#define SWRITEC(bufo, tabo) do { char* B_ = lds + (bufo); _Pragma("unroll") for (int i = 0; i < 4; ++i) { const int row = r0 + 16 * i; \
        *(u32x4*)(B_ + S_WL + row * S_WP + c0 * 16) = pw[i]; *(u32x4*)(B_ + S_QL + row * S_WP + c0 * 16) = pq[i]; *(u32x4*)(B_ + S_KL + row * S_KP + c0 * 16) = pk[i]; } \
        *(u32x4*)(B_ + S_QKL + rq * S_QKP + cq * 16) = pqk[0]; *(u32x4*)(B_ + S_QKL + (rq + 32) * S_QKP + cq * 16) = pqk[1]; \
        if (t2 < 64) { float* T_ = (float*)(lds + (tabo)); T_[t2] = __expf(pg); T_[64 + t2] = __expf(pgl - pg); if (t2 == 0) T_[128] = __expf(pgl); } } while (0)
    const int orow = t2 >> 2, oseg = t2 & 3;
    u32x4 zA[4], zB[4];
#define ZLOAD(dst, nn) do { const char* zc_ = (const char*)(PROJ + pj(mb0 + (size_t)(nn) * 64 + orow, C_GZ + h * 128 + oseg * 32)); _Pragma("unroll") for (int i = 0; i < 4; ++i) dst[i] = *(const u32x4*)(zc_ + i * 16); } while (0)
    float nwv[32];
    if (!is_compute) {
#pragma unroll
        for (int i = 0; i < 32; ++i) nwv[i] = F.gdn_norm_w[layer * 128 + oseg * 32 + i];
    }
#define OUTPUT(nn, OTO, Z) do { const char* op_ = lds + (OTO) + orow * S_OP + oseg * 64; float ov[32]; float ss = 0.f; \
        _Pragma("unroll") for (int i = 0; i < 4; ++i) { const u32x4 w = *(const u32x4*)(op_ + i * 16); ov[8 * i] = bf_lo(w.x); ov[8 * i + 1] = bf_hi(w.x); ov[8 * i + 2] = bf_lo(w.y); ov[8 * i + 3] = bf_hi(w.y); \
            ov[8 * i + 4] = bf_lo(w.z); ov[8 * i + 5] = bf_hi(w.z); ov[8 * i + 6] = bf_lo(w.w); ov[8 * i + 7] = bf_hi(w.w); } \
        _Pragma("unroll") for (int i = 0; i < 32; ++i) ss = __builtin_fmaf(ov[i], ov[i], ss); \
        ss += shx<1>(ss); ss += shx<2>(ss); \
        const float rs = frsq(ss * (1.0f / 128.0f) + RMS_EPS); \
        bf16_t* dp_ = MIXED + pj2(mb0 + (size_t)(nn) * 64 + orow, 1024 + h * 128 + oseg * 32); \
        _Pragma("unroll") for (int i = 0; i < 4; ++i) { const u32x4 z = Z[i]; u32x4 o; \
            o.x = cvtpk(ov[8 * i] * rs * nwv[8 * i] * bf_lo(z.x), ov[8 * i + 1] * rs * nwv[8 * i + 1] * bf_hi(z.x)); o.y = cvtpk(ov[8 * i + 2] * rs * nwv[8 * i + 2] * bf_lo(z.y), ov[8 * i + 3] * rs * nwv[8 * i + 3] * bf_hi(z.y)); \
            o.z = cvtpk(ov[8 * i + 4] * rs * nwv[8 * i + 4] * bf_lo(z.z), ov[8 * i + 5] * rs * nwv[8 * i + 5] * bf_hi(z.z)); o.w = cvtpk(ov[8 * i + 6] * rs * nwv[8 * i + 6] * bf_lo(z.w), ov[8 * i + 7] * rs * nwv[8 * i + 7] * bf_hi(z.w)); \
            *(u32x4*)(dp_ + i * 8) = o; } } while (0)
#define COMPUTE_STEP(n, CUR, UC, UN) do { \
        if ((n) + 1 < 64) { ULOAD(UN, (n) + 1); } \
        const char* Wl = lds + (CUR) * S_BUF + S_WL; const char* Ql = lds + (CUR) * S_BUF + S_QL; const char* Kl = lds + (CUR) * S_BUF + S_KL; const char* QKl = lds + (CUR) * S_BUF + S_QKL; \
        const float* EG = (const float*)(lds + S_TAB + (CUR) * S_TABSZ); const float* E2 = EG + 64; char* Ot = lds + S_OT + (CUR) * S_OTSZ; \
          \
        bf16x8 sb[2][4]; \
        _Pragma("unroll") for (int c = 0; c < 2; ++c) _Pragma("unroll") for (int s = 0; s < 4; ++s) { \
            const u32x4 w = {cvtpk(Sacc[c][2 * s][0], Sacc[c][2 * s][1]), cvtpk(Sacc[c][2 * s][2], Sacc[c][2 * s][3]), cvtpk(Sacc[c][2 * s + 1][0], Sacc[c][2 * s + 1][1]), cvtpk(Sacc[c][2 * s + 1][2], Sacc[c][2 * s + 1][3])}; \
            sb[c][s] = __builtin_bit_cast(bf16x8, w); } \
          \
        f32x4 vn[2][4], oo[2][4]; \
        bf16x8 wa[4], qa[4]; \
        _Pragma("unroll") for (int s = 0; s < 4; ++s) { const char* wr_ = Wl + fr * S_WP + 8 * g; const char* qr_ = Ql + fr * S_WP + 8 * g; wa[s] = frag2(wr_ + 64 * s, wr_ + 64 * s + 32); qa[s] = frag2(qr_ + 64 * s, qr_ + 64 * s + 32); } \
        _Pragma("unroll") for (int t = 0; t < 4; ++t) { \
            float eg4[4]; \
            _Pragma("unroll") for (int ii = 0; ii < 4; ++ii) eg4[ii] = EG[16 * t + 4 * g + ii]; \
            __builtin_amdgcn_sched_barrier(0); \
            f32x4 a1[2], a2[2]; \
            _Pragma("unroll") for (int c = 0; c < 2; ++c) { a1[c] = (f32x4){0.f, 0.f, 0.f, 0.f}; a2[c] = (f32x4){0.f, 0.f, 0.f, 0.f}; } \
            _Pragma("unroll") for (int s = 0; s < 4; ++s) _Pragma("unroll") for (int c = 0; c < 2; ++c) a1[c] = __builtin_amdgcn_mfma_f32_16x16x32_bf16(wa[s], sb[c][s], a1[c], 0, 0, 0); \
            __builtin_amdgcn_sched_barrier(0); \
            if (t < 3) { _Pragma("unroll") for (int s = 0; s < 4; ++s) { const char* wr_ = Wl + (16 * (t + 1) + fr) * S_WP + 8 * g; wa[s] = frag2(wr_ + 64 * s, wr_ + 64 * s + 32); } } \
            __builtin_amdgcn_sched_barrier(0); \
            _Pragma("unroll") for (int s = 0; s < 4; ++s) _Pragma("unroll") for (int c = 0; c < 2; ++c) a2[c] = __builtin_amdgcn_mfma_f32_16x16x32_bf16(qa[s], sb[c][s], a2[c], 0, 0, 0); \
            __builtin_amdgcn_sched_barrier(0); \
            if (t < 3) { _Pragma("unroll") for (int s = 0; s < 4; ++s) { const char* qr_ = Ql + (16 * (t + 1) + fr) * S_WP + 8 * g; qa[s] = frag2(qr_ + 64 * s, qr_ + 64 * s + 32); } } \
            _Pragma("unroll") for (int c = 0; c < 2; ++c) { const u32x2 uw = UC[c][t]; const float u0 = bf_lo(uw.x), u1 = bf_hi(uw.x), u2 = bf_lo(uw.y), u3 = bf_hi(uw.y); \
                vn[c][t] = (f32x4){u0 - a1[c][0], u1 - a1[c][1], u2 - a1[c][2], u3 - a1[c][3]}; \
                oo[c][t] = (f32x4){a2[c][0] * eg4[0], a2[c][1] * eg4[1], a2[c][2] * eg4[2], a2[c][3] * eg4[3]}; } } \
          \
        bf16x8 vb2[2][2], vb3[2][2]; \
        { _Pragma("unroll") for (int s2 = 0; s2 < 2; ++s2) { float e2v[8]; \
            _Pragma("unroll") for (int ii = 0; ii < 4; ++ii) { e2v[ii] = E2[32 * s2 + 4 * g + ii]; e2v[4 + ii] = E2[32 * s2 + 16 + 4 * g + ii]; } \
            _Pragma("unroll") for (int c = 0; c < 2; ++c) { \
            const u32x4 w = {cvtpk(vn[c][2 * s2][0], vn[c][2 * s2][1]), cvtpk(vn[c][2 * s2][2], vn[c][2 * s2][3]), cvtpk(vn[c][2 * s2 + 1][0], vn[c][2 * s2 + 1][1]), cvtpk(vn[c][2 * s2 + 1][2], vn[c][2 * s2 + 1][3])}; \
            vb2[c][s2] = __builtin_bit_cast(bf16x8, w); \
            const u32x4 w3 = {cvtpk(vn[c][2 * s2][0] * e2v[0], vn[c][2 * s2][1] * e2v[1]), cvtpk(vn[c][2 * s2][2] * e2v[2], vn[c][2 * s2][3] * e2v[3]), \
                              cvtpk(vn[c][2 * s2 + 1][0] * e2v[4], vn[c][2 * s2 + 1][1] * e2v[5]), cvtpk(vn[c][2 * s2 + 1][2] * e2v[6], vn[c][2 * s2 + 1][3] * e2v[7])}; \
            vb3[c][s2] = __builtin_bit_cast(bf16x8, w3); } } \
          __builtin_amdgcn_sched_barrier(0); \
          { const char* ar0 = QKl + fr * S_QKP + 8 * g; const bf16x8 f0 = frag2(ar0, ar0 + 32), f1 = frag2(ar0 + 16 * S_QKP, ar0 + 16 * S_QKP + 32); \
            _Pragma("unroll") for (int c = 0; c < 2; ++c) { oo[c][0] = __builtin_amdgcn_mfma_f32_16x16x32_bf16(f0, vb2[c][0], oo[c][0], 0, 0, 0); oo[c][1] = __builtin_amdgcn_mfma_f32_16x16x32_bf16(f1, vb2[c][0], oo[c][1], 0, 0, 0); } } \
          __builtin_amdgcn_sched_barrier(0); \
          { const char* ar2 = QKl + (32 + fr) * S_QKP + 8 * g; const bf16x8 f0 = frag2(ar2, ar2 + 32), f1 = frag2(ar2 + 64, ar2 + 96), f2 = frag2(ar2 + 16 * S_QKP, ar2 + 16 * S_QKP + 32), f3 = frag2(ar2 + 16 * S_QKP + 64, ar2 + 16 * S_QKP + 96); \
            _Pragma("unroll") for (int c = 0; c < 2; ++c) { oo[c][2] = __builtin_amdgcn_mfma_f32_16x16x32_bf16(f0, vb2[c][0], oo[c][2], 0, 0, 0); oo[c][3] = __builtin_amdgcn_mfma_f32_16x16x32_bf16(f2, vb2[c][0], oo[c][3], 0, 0, 0); \
                oo[c][2] = __builtin_amdgcn_mfma_f32_16x16x32_bf16(f1, vb2[c][1], oo[c][2], 0, 0, 0); oo[c][3] = __builtin_amdgcn_mfma_f32_16x16x32_bf16(f3, vb2[c][1], oo[c][3], 0, 0, 0); } } \
          __builtin_amdgcn_sched_barrier(0); } \
          \
        { const float aa = EG[128]; \
          const unsigned kaddr = (unsigned)(uintptr_t)Kl + (unsigned)((4 * g + ((lane & 15) >> 2)) * S_KP + (lane & 3) * 8); \
          _Pragma("unroll") for (int c = 0; c < 2; ++c) _Pragma("unroll") for (int db = 0; db < 8; ++db) Sacc[c][db] = Sacc[c][db] * aa; \
          _Pragma("unroll") for (int dp = 0; dp < 4; ++dp) { s16x4 klo[2][2], khi[2][2]; \
            _Pragma("unroll") for (int dd = 0; dd < 2; ++dd) _Pragma("unroll") for (int s2 = 0; s2 < 2; ++s2) { \
                asm volatile("ds_read_b64_tr_b16 %0, %1 offset:%2" : "=&v"(klo[dd][s2]) : "v"(kaddr), "i"(s2 * 32 * S_KP + (2 * dp + dd) * 32) : "memory"); \
                asm volatile("ds_read_b64_tr_b16 %0, %1 offset:%2" : "=&v"(khi[dd][s2]) : "v"(kaddr), "i"(s2 * 32 * S_KP + 16 * S_KP + (2 * dp + dd) * 32) : "memory"); } \
            asm volatile("s_waitcnt lgkmcnt(0)" ::: "memory"); __builtin_amdgcn_sched_barrier(0); \
            _Pragma("unroll") for (int s2 = 0; s2 < 2; ++s2) _Pragma("unroll") for (int dd = 0; dd < 2; ++dd) { const s16x4 lo_ = klo[dd][s2], hi_ = khi[dd][s2]; \
                const bf16x8 kfr = (bf16x8){lo_[0], lo_[1], lo_[2], lo_[3], hi_[0], hi_[1], hi_[2], hi_[3]}; \
                _Pragma("unroll") for (int c = 0; c < 2; ++c) Sacc[c][2 * dp + dd] = __builtin_amdgcn_mfma_f32_16x16x32_bf16(kfr, vb3[c][s2], Sacc[c][2 * dp + dd], 0, 0, 0); } \
            __builtin_amdgcn_sched_barrier(0); } } \
          \
        _Pragma("unroll") for (int c = 0; c < 2; ++c) _Pragma("unroll") for (int t = 0; t < 4; ++t) _Pragma("unroll") for (int ii = 0; ii < 4; ++ii) \
            *(bf16_t*)(Ot + (16 * t + 4 * g + ii) * S_OP + (vb + 16 * c + fr) * 2) = (bf16_t)(cvtpk(oo[c][t][ii], 0.f) & 0xffffu); \
    } while (0)
#define IO_STEP(n, NXT, ZC, ZN) do { \
        if ((n) + 1 < 64) { SWRITEC((NXT) * S_BUF, S_TAB + (NXT) * S_TABSZ); } \
        if ((n) < 64) { ZLOAD(ZN, (n)); } \
        if ((n) + 2 < 64) { SLOADC((n) + 2); } \
        if ((n) >= 1) { OUTPUT((n) - 1, S_OT + (NXT) * S_OTSZ, ZC); } \
    } while (0)
    if (is_compute) { ULOAD(uA, 0); }
    else { SLOADC(0); SWRITEC(0, S_TAB); SLOADC(1); }
    __syncthreads();
#define SCAN_BAR() do { asm volatile("s_waitcnt lgkmcnt(0)" ::: "memory"); __builtin_amdgcn_s_barrier(); asm volatile("" ::: "memory"); } while (0)
    if (is_compute) {
#pragma unroll 1
        for (int n = 0; n < 64; n += 2) {
            COMPUTE_STEP(n, 0, uA, uB); SCAN_BAR();
            COMPUTE_STEP(n + 1, 1, uB, uA); SCAN_BAR();
        }
    } else {
#pragma unroll 1
        for (int n = 0; n < 64; n += 2) {
            IO_STEP(n, 1, zB, zA); SCAN_BAR();
            IO_STEP(n + 1, 0, zA, zB); SCAN_BAR();
        }
        OUTPUT(63, S_OT + 1 * S_OTSZ, zB);
    }
#undef COMPUTE_STEP
#undef IO_STEP
#undef OUTPUT
#undef ZLOAD
#undef SLOADC
#undef SWRITEC
#undef ULOAD
}
}

#define XB_TMO      128
#define XB_XCNT(j)  (256  + 64 * (j))
#define XB_XSUB(j)  (1280 + 64 * (j))
#define XB_XGEN(j)  (2304 + 64 * (j))
#define XB_TOP      3328
#define XB_TOPGEN   3392
#define XCD_BAR_WORDS 3456
#define XB_SPIN_CAP (1u << 18)

__device__ __forceinline__ unsigned xb_ld(unsigned* p)              { return __hip_atomic_load(p, __ATOMIC_RELAXED, __HIP_MEMORY_SCOPE_AGENT); }
__device__ __forceinline__ unsigned xb_add(unsigned* p, unsigned v) { return __hip_atomic_fetch_add(p, v, __ATOMIC_RELAXED, __HIP_MEMORY_SCOPE_AGENT); }
__device__ __forceinline__ unsigned xb_xcc_id() { return (unsigned)__builtin_amdgcn_s_getreg((3 << 11) | 20) & 0xFu; }
#define XB_SPIN(cond, bar) do { unsigned _sp = 0; while (cond) { __builtin_amdgcn_s_sleep(1); \
    if ((++_sp & 255u) == 0u) { if (xb_ld(&(bar)[XB_TMO])) break; if (_sp > XB_SPIN_CAP) { atomicAdd(&(bar)[XB_TMO], 1u); break; } } } } while (0)

struct XcdBarrier {
    unsigned* bar; unsigned x;
    volatile LAS unsigned* st;
};

__device__ __forceinline__ XcdBarrier xcd_barrier_post(unsigned* bar, volatile LAS unsigned* st) {
    XcdBarrier b; b.bar = bar; b.x = xb_xcc_id(); b.st = st;
    if (threadIdx.x == 0) (void)xb_add(&bar[XB_XCNT(b.x)], 1u);
    return b;
}
__device__ __forceinline__ void xcd_barrier_complete(unsigned* bar, unsigned x, unsigned& nloc, unsigned& nx) {
    const unsigned G = gridDim.x * gridDim.y * gridDim.z;
    unsigned sum, cnt, mine, sp = 0u;
    for (;;) {
        sum = 0u; cnt = 0u; mine = 0u;
#pragma unroll
        for (unsigned j = 0; j < 16; ++j) { const unsigned c = xb_ld(&bar[XB_XCNT(j)]); sum += c; cnt += (c > 0u) ? 1u : 0u; mine = (j == x) ? c : mine; }
        if (sum == G) break;
        __builtin_amdgcn_s_sleep(1);
        if ((++sp & 255u) == 0u) { if (xb_ld(&bar[XB_TMO])) break; if (sp > XB_SPIN_CAP) { atomicAdd(&bar[XB_TMO], 1u); break; } }
    }
    nloc = mine > 0u ? mine : 1u; nx = cnt > 0u ? cnt : 1u;
}

__device__ __forceinline__ void xcd_barrier(const XcdBarrier& b, const int wave_id) {
    asm volatile("s_waitcnt vmcnt(0)" ::: "memory");
    __syncthreads();
    if (wave_id == 0 && b.st[0] == 0u) {
        const int l_ = fresh_tid(0);
        const unsigned G_ = gridDim.x * gridDim.y * gridDim.z;
        unsigned sum_, cnt_, mine_, sp_ = 0u;
        for (;;) {
            const unsigned c_ = (l_ < 16) ? xb_ld(&b.bar[XB_XCNT(l_)]) : 0u;
            sum_ = 0u; cnt_ = 0u;
#pragma unroll
            for (int j = 0; j < 16; ++j) { const unsigned cj = (unsigned)__builtin_amdgcn_readlane((int)c_, j); sum_ += cj; cnt_ += (cj > 0u) ? 1u : 0u; }
            mine_ = (unsigned)__builtin_amdgcn_readlane((int)c_, (int)b.x);
            if (sum_ == G_) break;
            __builtin_amdgcn_s_sleep(1);
            if ((++sp_ & 255u) == 0u) { if (__builtin_amdgcn_readfirstlane((int)xb_ld(&b.bar[XB_TMO]))) break; if (sp_ > XB_SPIN_CAP) { if (l_ == 0) atomicAdd(&b.bar[XB_TMO], 1u); break; } }
        }
        if (l_ == 0) { b.st[0] = mine_ > 0u ? mine_ : 1u; b.st[1] = cnt_ > 0u ? cnt_ : 1u; }
        asm volatile("s_waitcnt lgkmcnt(0)" ::: "memory");
    }
    if (fresh_tid(wave_id) == 0) {
        unsigned* bar = b.bar; asm volatile("" : "+s"(bar));
        __builtin_amdgcn_s_waitcnt(0);
        unsigned nloc = b.st[0], nx = b.st[1];
        if (nloc == 0u) { xcd_barrier_complete(bar, b.x, nloc, nx); b.st[0] = nloc; b.st[1] = nx; }
        const unsigned old = xb_add(&bar[XB_XSUB(b.x)], 1u);
        const unsigned gen = old / nloc;
        if (old + 1u == (gen + 1u) * nloc) {
            __builtin_amdgcn_fence(__ATOMIC_RELEASE, "agent");
            asm volatile("s_waitcnt vmcnt(0)" ::: "memory");
            const unsigned og = xb_add(&bar[XB_TOP], 1u);
            const unsigned tg = og / nx;
            if (og + 1u == (tg + 1u) * nx) xb_add(&bar[XB_TOPGEN], 1u);
            else XB_SPIN(xb_ld(&bar[XB_TOPGEN]) == tg, bar);
            __builtin_amdgcn_fence(__ATOMIC_ACQUIRE, "agent");
            xb_add(&bar[XB_XGEN(b.x)], 1u);
            asm volatile("s_waitcnt vmcnt(0)" ::: "memory");
        } else {
            XB_SPIN(xb_ld(&bar[XB_XGEN(b.x)]) == gen, bar);
            __builtin_amdgcn_fence(__ATOMIC_ACQUIRE, "agent");
            asm volatile("s_waitcnt vmcnt(0)" ::: "memory");
        }
    }
    __syncthreads();
}

__global__ void __launch_bounds__(512, 2) hybrid_fwd(Args args) {
    extern __shared__ __attribute__((aligned(16))) unsigned char lds[];
    cg::grid_group grid = cg::this_grid();
    Ctx F;
    F.tid = threadIdx.x; F.lane = F.tid & 63; F.wave = __builtin_amdgcn_readfirstlane(F.tid >> 6); F.bid = blockIdx.x; F.G = gridDim.x;
    F.x = args.in[0]; F.norm_w = args.in[1]; F.w_in = args.in[2]; F.w_out = args.in[3]; F.lq1 = args.in[4]; F.lk1 = args.in[5]; F.lq2 = args.in[6]; F.lk2 = args.in[7];
    F.subln_w = args.in[8]; F.rel_bias = args.in[9]; F.conv_w = args.in[10]; F.a_log = args.in[11]; F.dt_bias = args.in[12]; F.gdn_norm_w = args.in[13]; F.final_w = args.in[14];
    F.out = args.out; F.ws = args.ws;
    LAS unsigned char* ldsl = (LAS unsigned char*)lds;
    LAS float* rstd_l = (LAS float*)(ldsl + LDSX_OFF);
    volatile LAS unsigned* barst = (volatile LAS unsigned*)(ldsl + LDS_BARST);
    if (F.tid < 2) barst[F.tid] = 0u;
    __syncthreads();
    if (F.bid == 0) { u32x4* cw = (u32x4*)(F.ws + WS_CTL);
#pragma unroll
        for (int i = 0; i < 8; ++i) cw[i * 512 + F.tid] = (u32x4){0u, 0u, 0u, 0u}; }

    grid.sync();
    XcdBarrier bar = xcd_barrier_post((unsigned*)(F.ws + WS_CTL) + 4096, barst);
    for (int rep_ = 0; rep_ < REP_P0; ++rep_) p0_prologue(F, ldsl);
    xcd_barrier(bar, F.wave);

#pragma unroll 1
    for (int layer = 0; layer < 2; ++layer) {
        const float lambda_init = (layer == 0) ? 0.2f : 0.35550906759f;
        {
            relaunder(F);
#ifndef REP_BA
#define REP_BA 1
#endif
            for (int rb_ = 0; rb_ < REP_BA; ++rb_) ba_job(F, ldsl, layer);
            pg8::Gemm g{(const bf16_t*)(F.ws + WS_XB), (const bf16_t*)(F.ws + WS_WIN) + (size_t)layer * NPROJ * DM, M, NPROJ, DM};
            pg8::StaticOrder S; S.init(M, NPROJ, F.G, F.bid);
            pg8::Unit u0; S.next(0, u0);
            rstd_table(F, rstd_l, u0.pm * 256, 256);
            __syncthreads();
            pg8::EpiProj E{(bf16_t*)(F.ws + WS_PROJ), rstd_l, QSCALE};
            for (int rep_ = 0; rep_ < REP_P1; ++rep_) pg8::gemm_phase<pg8::EpiProj, pg8::StaticOrder, PG8_ALIGN_P1, PG8_SP2_ALL>(ldsl, g, S, E, F.wave);
        }
        xcd_barrier(bar, F.wave);
        relaunder(F);
        { const int gw = F.bid * 8 + F.wave; if (gw < 2048) gdn::chunk_prep(F, (char*)lds + F.wave * gdn::WAVE_LDS, layer, gw); }
        xcd_barrier(bar, F.wave);
        relaunder(F);
        { int bidv = F.bid; asm volatile("" : "+s"(bidv));
          if (bidv < 32) {
            for (int rep_ = 0; rep_ < REP_SCAN; ++rep_) gdn::scan_mfma(F, (char*)lds, layer, bidv);
          } }
        relaunder(F);
#ifdef PROBE_SERIAL
        xcd_barrier(bar, F.wave);
#endif
        {
            float d1 = F.lq1[layer * 64 + F.lane] * F.lk1[layer * 64 + F.lane], d2 = F.lq2[layer * 64 + F.lane] * F.lk2[layer * 64 + F.lane];
            d1 = wave_sum(d1); d2 = wave_sum(d2);
            const float lam = __expf(d1) - __expf(d2) + lambda_init;
            unsigned* wq = (unsigned*)(F.ws + WS_CTL) + 8192 + layer * 64;
            volatile LAS unsigned* wql = (volatile LAS unsigned*)(ldsl + LDS_BARST + 16);
            bool have = false; int uraw = 0;
            for (;;) {
                if (!have) {
                    if (F.tid == 0) wql[0] = __hip_atomic_fetch_add(wq, 1u, __ATOMIC_RELAXED, __HIP_MEMORY_SCOPE_AGENT);
                    __syncthreads();
                    uraw = (int)wql[0];
                    __syncthreads(); }
                have = false;
                int u = uraw;
                if (layer == 0) {
                    constexpr int WB = 32, NWB = (P0_LAYER_ITEMS + WB - 1) / WB;
                    if (u < 4 * NWB && (u & 3) == 3) {
                        relaunder(F);
#pragma unroll 1
                        for (int k = 0; k < WB / 8; ++k) { const int it = (u >> 2) * WB + k * 8 + F.wave; if (it < P0_LAYER_ITEMS) p0_weight_item(F, (LAS float*)(ldsl + F.wave * 17408), 1, it); }
                        __syncthreads();
                        continue; }
                    u -= (u < 4 * NWB) ? (u >> 2) : NWB; }
                if (u >= 512) break;
                const int qb = 15 - (u >> 5), bh = u & 31;
                if (F.wave >= 4) att::attn_unit<true>(F, (char*)lds, layer, bh >> 3, bh & 7, qb, lam, 1.0f - lambda_init, wq, wql);
                else att::attn_unit<false>(F, (char*)lds, layer, bh >> 3, bh & 7, qb, lam, 1.0f - lambda_init, wq, wql);
                uraw = (int)wql[0]; have = true;
            }
        }
        xcd_barrier(bar, F.wave);
        {
            relaunder(F);
            pg8::Gemm g{(const bf16_t*)(F.ws + WS_MIXED), (const bf16_t*)(F.ws + WS_WOUT) + (size_t)layer * DM * DM, M, DM, DM};
            pg8::StaticOrder S; S.init(M, DM, F.G, F.bid);
            { pg8::EpiOut<true> E{nullptr, (bf16_t*)(F.ws + WS_XB), (float*)(F.ws + WS_ROWSQ)};
                pg8::gemm_phase<pg8::EpiOut<true>, pg8::StaticOrder, true, PG8_SP2_ALL>(ldsl, g, S, E, F.wave); }
        }
        xcd_barrier(bar, F.wave);
    }
    {
        relaunder(F);
        const int gw = F.bid * 8 + F.wave, NGW = F.G * 8; const float* RQ = (const float*)(F.ws + WS_ROWSQ);
        for (int m = gw; m < M; m += NGW) {
            float s = (F.lane < 32) ? RQ[(size_t)m * 32 + F.lane] : 0.f; s = wave_sum(s);
            const float rs = frsq(s * (1.0f / DM) + RMS_EPS);
            u32x2 xv8[8]; f32x4 w8[8];
            const bf16_t* xr = (const bf16_t*)(F.ws + WS_XB) + pj2((size_t)m, 4 * F.lane); f32x4* orow = (f32x4*)(F.out + (size_t)m * DM) + F.lane; const f32x4* wr_ = (const f32x4*)F.final_w + F.lane;
#pragma unroll
            for (int j = 0; j < 8; ++j) { xv8[j] = *(const u32x2*)(xr + (size_t)j * 8 * 2048); w8[j] = wr_[64 * j]; }
#pragma unroll
            for (int j = 0; j < 8; ++j) { const u32x2 xv = xv8[j]; const f32x4 w = w8[j];
                orow[64 * j] = (f32x4){bf_lo(xv.x) * rs * w[0], bf_hi(xv.x) * rs * w[1], bf_lo(xv.y) * rs * w[2], bf_hi(xv.y) * rs * w[3]}; }
        }
    }
}

extern "C" void kernel_launch(void* const* d_in, const int* in_sizes, int n_in, void* d_out, int out_size, void* d_ws, size_t ws_size, hipStream_t stream) {
    static int grid = 0;
    if (grid == 0) {
        if (n_in != 15 || in_sizes[0] != M * DM || out_size != M * DM || ws_size < WS_END) {
            fprintf(stderr, "kernel_launch: unexpected shapes (n_in %d, in0 %d, out %d, ws %zu < %zu)\n", n_in, n_in > 0 ? in_sizes[0] : -1, out_size, ws_size, (size_t)WS_END); grid = -1; return; }
        int dev = 0, cus = 0, per_cu = 0;
        (void)hipGetDevice(&dev); (void)hipDeviceGetAttribute(&cus, hipDeviceAttributeMultiprocessorCount, dev);
        if (hipFuncSetAttribute((const void*)hybrid_fwd, hipFuncAttributeMaxDynamicSharedMemorySize, LDS_BYTES) != hipSuccess) { fprintf(stderr, "kernel_launch: hipFuncSetAttribute failed\n"); grid = -1; return; }
        (void)hipOccupancyMaxActiveBlocksPerMultiprocessor(&per_cu, (const void*)hybrid_fwd, 512, LDS_BYTES);
        if (per_cu < 1) { fprintf(stderr, "kernel_launch: occupancy query says %d blocks per CU\n", per_cu); grid = -1; return; }
        grid = cus;
        if (grid != 256) fprintf(stderr, "kernel_launch: note: %d CUs (built for 256)\n", grid);
    }
    if (grid < 0) return;
    Args a{};
    for (int i = 0; i < 15; ++i) a.in[i] = (const float*)d_in[i];
    a.out = (float*)d_out; a.ws = (unsigned char*)d_ws;
    void* kargs[] = {&a};
    hipError_t e = hipLaunchCooperativeKernel((const void*)hybrid_fwd, dim3(grid), dim3(512), kargs, LDS_BYTES, stream);
    if (e != hipSuccess) fprintf(stderr, "kernel_launch: cooperative launch failed: %s\n", hipGetErrorString(e));
}
```

```cpp
#include <hip/hip_runtime.h>
#include <hip/hip_cooperative_groups.h>
#include <cstdio>
#include <cstdint>
namespace cg = cooperative_groups;
namespace pg8 {
#define PG8_LAS __attribute__((address_space(3)))
typedef unsigned short bf16_t;
typedef short bf16x8 __attribute__((ext_vector_type(8)));
typedef float f32x4 __attribute__((ext_vector_type(4)));
typedef unsigned u32x4 __attribute__((ext_vector_type(4)));
constexpr int BM = 256, BK = 64, HALF = 128, HTB = HALF * BK * 2  , STAGE_BYTES = 8 * HTB, NXCD = 8, WGM = 8;

__host__ __device__ __forceinline__ int lds_byte(int r, int c) { const int st = (r >> 4) * 2 + (c >> 5), rr = r & 15, cc = c & 31, ob = rr * 64 + cc * 2; return st * 1024 + (ob ^ (((ob >> 9) & 1) << 5)); }
__host__ __device__ __forceinline__ void stage_rc(int b, int& R, int& C) { const int st = b / 1024, sb = b % 1024, swz = sb ^ (((sb >> 9) & 1) << 5); R = (st >> 1) * 16 + swz / 64; C = (st & 1) * 32 + (swz % 64) / 2; }
__host__ __device__ __forceinline__ int perm32(int rho) { const int n = rho >> 4, i = rho & 15; return 8 * (i >> 2) + 4 * n + (i & 3); }

struct Unit { int pm, pn; };
struct Gemm { const bf16_t* A; const bf16_t* Bt; int M, N, K; };

struct StaticOrder {
    int nM, nN, nwg, G, c;
    __host__ __device__ void init(int M, int N, int G_, int c_) { nM = M / BM; nN = N / BM; nwg = nM * nN; G = G_; c = c_; }
    __host__ __device__ bool next(int i, Unit& u) const {
        const long L = (long)i * G + c; if (L >= nwg) return false;
        int wgid = (int)L; { const int q = nwg / NXCD, r = nwg % NXCD, xcd = wgid % NXCD, off = wgid / NXCD; wgid = (xcd < r ? xcd * (q + 1) : r * (q + 1) + (xcd - r) * q) + off; }
        const int nig = WGM * nN, gid = wgid / nig, fm = gid * WGM, gsz = (nM - fm) < WGM ? (nM - fm) : WGM;
        u.pm = fm + ((wgid % nig) % gsz); u.pn = (wgid % nig) / gsz; return true;
    }
    __device__ __forceinline__ void a_ready(const Unit&) const {}
    __device__ __forceinline__ void done(const Unit&) const {}
};


__device__ __forceinline__ unsigned cvt_pk_bf16(float lo, float hi) { unsigned r; asm volatile("v_cvt_pk_bf16_f32 %0, %1, %2" : "=v"(r) : "v"(lo), "v"(hi)); return r; }
typedef unsigned u32x2 __attribute__((ext_vector_type(2)));

struct EpiProj {
    static constexpr bool PERM = true, AFTER_DRAIN = false, IDEMPOTENT = true;
    bf16_t* O; const PG8_LAS float* rstd; float qscale;
    __device__ __forceinline__ void operator()(const f32x4 (&acc)[2][2][4][2], const Unit& u, int wr, int wc, int fr, int fq) const {
        const int col0 = u.pn * BM + wc * 32 + 8 * fq;
        const float sc = (u.pn < 4) ? qscale : 1.f;
        const bool act = (u.pn >= 12 && u.pn < 16) || (u.pn >= 28);
#pragma unroll
        for (int ai = 0; ai < 2; ++ai)
#pragma unroll
            for (int m = 0; m < 4; ++m) { const int r = ai * HALF + wr * 64 + m * 16 + fr; const float s = rstd[r] * sc;
                bf16_t* rowp = O + ((size_t)((u.pm * 4 + ai * 2 + wr) * 256 + u.pn * 8 + wc) * 2048 + (m * 16 + fr) * 32 + 8 * fq);
#pragma unroll
                for (int bj = 0; bj < 2; ++bj) { f32x4 v0 = acc[ai][bj][m][0] * s, v1 = acc[ai][bj][m][1] * s;
                    if (act) { typedef float f32x2p __attribute__((ext_vector_type(2)));
                        _Pragma("unroll") for (int e_ = 0; e_ < 4; e_ += 2) { f32x2p a = {v0[e_], v0[e_ + 1]}, c = {v1[e_], v1[e_ + 1]};
                            f32x2p ea = a * (f32x2p){-1.4426950408889634f, -1.4426950408889634f}, ec = c * (f32x2p){-1.4426950408889634f, -1.4426950408889634f};
                            ea = (f32x2p){__builtin_amdgcn_exp2f(ea.x), __builtin_amdgcn_exp2f(ea.y)} + (f32x2p){1.f, 1.f}; ec = (f32x2p){__builtin_amdgcn_exp2f(ec.x), __builtin_amdgcn_exp2f(ec.y)} + (f32x2p){1.f, 1.f};
                            a = a * (f32x2p){__builtin_amdgcn_rcpf(ea.x), __builtin_amdgcn_rcpf(ea.y)}; c = c * (f32x2p){__builtin_amdgcn_rcpf(ec.x), __builtin_amdgcn_rcpf(ec.y)};
                            v0[e_] = a.x; v0[e_ + 1] = a.y; v1[e_] = c.x; v1[e_ + 1] = c.y; } }
                    u32x4 w; w.x = cvt_pk_bf16(v0[0], v0[1]); w.y = cvt_pk_bf16(v0[2], v0[3]); w.z = cvt_pk_bf16(v1[0], v1[1]); w.w = cvt_pk_bf16(v1[2], v1[3]);
                    *(u32x4*)(rowp + bj * 4 * 2048) = w;
                } }
    }
};
template <bool RES_BF16> struct EpiOut {
    static constexpr bool PERM = true, AFTER_DRAIN = false, IDEMPOTENT = !RES_BF16;
    const float* res; bf16_t* xb; float* rowsq;
    __device__ __forceinline__ void operator()(const f32x4 (&acc)[2][2][4][2], const Unit& u, int wr, int wc, int fr, int fq) const {
        u32x4 rbv[2][4][2];
        if constexpr (RES_BF16) {
#pragma unroll
            for (int ai = 0; ai < 2; ++ai)
#pragma unroll
                for (int m = 0; m < 4; ++m) { const bf16_t* bp = xb + ((size_t)((u.pm * 4 + ai * 2 + wr) * 64 + u.pn * 8 + wc) * 2048 + (m * 16 + fr) * 32 + 8 * fq);
                    rbv[ai][m][0] = *(const u32x4*)bp; rbv[ai][m][1] = *(const u32x4*)(bp + 4 * 2048); }
            asm volatile("" ::: "memory"); }
        const int col0 = u.pn * BM + wc * 32 + 8 * fq;
#pragma unroll
        for (int ai = 0; ai < 2; ++ai)
#pragma unroll
            for (int m = 0; m < 4; ++m) { const int row = u.pm * BM + ai * HALF + wr * 64 + m * 16 + fr; float ss = 0.f;
                bf16_t* bp = xb + ((size_t)((u.pm * 4 + ai * 2 + wr) * 64 + u.pn * 8 + wc) * 2048 + (m * 16 + fr) * 32 + 8 * fq);
#pragma unroll
                for (int bj = 0; bj < 2; ++bj) { f32x4 r0, r1;
                    if constexpr (RES_BF16) { const u32x4 rb = rbv[ai][m][bj];
                        r0 = (f32x4){__uint_as_float(rb.x << 16), __uint_as_float(rb.x & 0xffff0000u), __uint_as_float(rb.y << 16), __uint_as_float(rb.y & 0xffff0000u)};
                        r1 = (f32x4){__uint_as_float(rb.z << 16), __uint_as_float(rb.z & 0xffff0000u), __uint_as_float(rb.w << 16), __uint_as_float(rb.w & 0xffff0000u)}; }
                    else { const float* rp = res + (size_t)row * 2048 + col0 + bj * HALF; r0 = *(const f32x4*)rp; r1 = *(const f32x4*)(rp + 4); }
                    const f32x4 v0 = r0 + acc[ai][bj][m][0], v1 = r1 + acc[ai][bj][m][1];
                    u32x4 w; w.x = cvt_pk_bf16(v0[0], v0[1]); w.y = cvt_pk_bf16(v0[2], v0[3]); w.z = cvt_pk_bf16(v1[0], v1[1]); w.w = cvt_pk_bf16(v1[2], v1[3]);
                    *(u32x4*)(bp + bj * 4 * 2048) = w;
                    ss += ((v0[0] * v0[0] + v0[1] * v0[1]) + (v0[2] * v0[2] + v0[3] * v0[3])) + ((v1[0] * v1[0] + v1[1] * v1[1]) + (v1[2] * v1[2] + v1[3] * v1[3])); }
                ss += __builtin_bit_cast(float, __builtin_amdgcn_ds_swizzle(__builtin_bit_cast(int, ss), (16 << 10) | 0x1F));
                { auto rr = __builtin_amdgcn_permlane32_swap(__float_as_uint(ss), __float_as_uint(ss), false, false); ss = __uint_as_float(rr[0]) + __uint_as_float(rr[1]); }
                if (fq == 0) rowsq[(size_t)row * 32 + u.pn * 4 + wc] = ss; }
    }
};

template <class Epi, class Sched, bool ALIGN_EPI = false, bool SP2 = false>
__device__ __forceinline__ void gemm_phase(PG8_LAS unsigned char* lds, const Gemm g, const Sched& S, const Epi& E, const int wave_id) {
    int lane_; asm volatile("v_mbcnt_lo_u32_b32 %0, -1, 0\n\tv_mbcnt_hi_u32_b32 %0, -1, %0" : "=v"(lane_));
    const int wid = wave_id, tid = wid * 64 + lane_, lane = lane_, wr = wid >> 2, wc = wid & 3, fr = lane & 15, fq = lane >> 4;
    const int K = g.K, nt = K / BK;
    unsigned voffA[2], voffB[2];
#pragma unroll
    for (int i = 0; i < 2; ++i) { int R, C; stage_rc(tid * 16 + i * 8192, R, C); const int Rb = Epi::PERM ? ((R & ~31) + perm32(R & 31)) : R;
        voffA[i] = (unsigned)(((R >> 6) * (K / 32) + (C >> 5)) * 2048 + (R & 63) * 32 + (C & 31)) * 2u; voffB[i] = (unsigned)(((Rb >> 6) * (K / 32) + (C >> 5)) * 2048 + (Rb & 63) * 32 + (C & 31)) * 2u; }
    const size_t kstep = (size_t)(2 * 2048 * 2);
    const size_t kstepA = (size_t)(2 * 2048 * 2);
    const size_t hstep = (size_t)HALF * K * 2;
    const size_t tstep = 2 * hstep;
    const unsigned ldsw = (unsigned)wid * 1024u;
    const int aoff = lds_byte(wr * 64 + fr, fq * 8), boff = lds_byte(wc * 32 + fr, fq * 8);
#define PG8_SA(b, h) (((b) * 2 + (h)) * HTB)
#define PG8_SB(b, h) ((4 + (b) * 2 + (h)) * HTB)
#define PG8_STAGE(bufoff, gbase, voff) do { _Pragma("unroll") for (int _i = 0; _i < 2; ++_i) \
        __builtin_amdgcn_global_load_lds((const unsigned*)((const char*)(gbase) + (voff)[_i]), (PG8_LAS unsigned*)(lds + (bufoff) + ldsw + _i * 8192), 16, 0, 0); } while (0)
#define PG8_LDA(dst, b, h) do { _Pragma("unroll") for (int m = 0; m < 4; ++m) _Pragma("unroll") for (int k = 0; k < 2; ++k) dst[m][k] = *(const PG8_LAS bf16x8*)(lds + PG8_SA(b, h) + aoff + m * 2048 + k * 1024); } while (0)
#define PG8_LDB(dst, b, h) do { _Pragma("unroll") for (int n = 0; n < 2; ++n) _Pragma("unroll") for (int k = 0; k < 2; ++k) dst[n][k] = *(const PG8_LAS bf16x8*)(lds + PG8_SB(b, h) + boff + n * 2048 + k * 1024); } while (0)
#define PG8_MMA(ai, bj, At, Bt) do { __builtin_amdgcn_s_setprio(1); _Pragma("unroll") for (int m = 0; m < 4; ++m) _Pragma("unroll") for (int n = 0; n < 2; ++n) _Pragma("unroll") for (int k = 0; k < 2; ++k) \
        acc[ai][bj][m][n] = __builtin_amdgcn_mfma_f32_16x16x32_bf16(Bt[n][k], At[m][k], acc[ai][bj][m][n], 0, 0, 0); __builtin_amdgcn_s_setprio(0); } while (0)
#define PG8_WAIT_V(n) asm volatile("s_waitcnt vmcnt(" #n ")" ::: "memory")
#define PG8_WAIT_L(n) asm volatile("s_waitcnt lgkmcnt(" #n ")" ::: "memory")
#define PG8_BAR __builtin_amdgcn_s_barrier()
#define PG8_SCHED __builtin_amdgcn_sched_barrier(0)
    Unit cur, nxt; int ui = 0;
    if (!S.next(0, cur)) return;
    f32x4 acc[2][2][4][2];
#pragma unroll
    for (int a = 0; a < 2; ++a)
#pragma unroll
        for (int b = 0; b < 2; ++b)
#pragma unroll
            for (int m = 0; m < 4; ++m)
#pragma unroll
                for (int n = 0; n < 2; ++n) acc[a][b][m][n] = (f32x4){0.f, 0.f, 0.f, 0.f};
    bf16x8 At[4][2], B0[2][2], B1[2][2];
    const char* cA = (const char*)g.A + (size_t)cur.pm * tstep; const char* cB = (const char*)g.Bt + (size_t)cur.pn * tstep;
    S.a_ready(cur);
    if constexpr (SP2) {
        PG8_STAGE(PG8_SB(0, 0), cB, voffB); PG8_STAGE(PG8_SB(0, 1), cB + hstep, voffB); PG8_STAGE(PG8_SA(0, 0), cA, voffA); PG8_STAGE(PG8_SA(0, 1), cA + hstep, voffA);
        if (wr == 1) PG8_BAR;
        PG8_WAIT_V(2); PG8_BAR;
        PG8_STAGE(PG8_SB(1, 0), cB + kstep, voffB); PG8_STAGE(PG8_SA(1, 0), cA + kstepA, voffA); PG8_STAGE(PG8_SB(1, 1), cB + hstep + kstep, voffB);
        PG8_WAIT_V(6); PG8_BAR;
    } else {
        PG8_STAGE(PG8_SB(0, 0), cB, voffB); PG8_STAGE(PG8_SA(0, 0), cA, voffA); PG8_STAGE(PG8_SB(0, 1), cB + hstep, voffB); PG8_STAGE(PG8_SA(0, 1), cA + hstep, voffA);
        if (wr == 1) PG8_BAR;
        PG8_WAIT_V(4); PG8_BAR;
        PG8_STAGE(PG8_SB(1, 0), cB + kstep, voffB); PG8_STAGE(PG8_SA(1, 0), cA + kstepA, voffA); PG8_STAGE(PG8_SB(1, 1), cB + hstep + kstep, voffB);
        PG8_WAIT_V(6); PG8_BAR;
    }
    for (;;) {
        const bool has_next = S.next(ui + 1, nxt);
        const char* nA = has_next ? (const char*)g.A + (size_t)nxt.pm * tstep : cA; const char* nB = has_next ? (const char*)g.Bt + (size_t)nxt.pn * tstep : cB;
        for (int t = 0; t < nt; t += 2) {
            const bool last = (t == nt - 2);
            const char* a1 = cA + (size_t)(t + 1) * kstepA;
            const char* a2 = last ? nA : cA + (size_t)(t + 2) * kstepA; const char* b2 = last ? nB : cB + (size_t)(t + 2) * kstep;
            const char* a3 = a2 + kstepA; const char* b3 = b2 + kstep;
            if (last && has_next) S.a_ready(nxt);
            if constexpr (SP2) {
            PG8_LDB(B0, 0, 0); PG8_LDB(B1, 0, 1); PG8_SCHED; PG8_LDA(At, 0, 0); PG8_STAGE(PG8_SA(1, 1), a1 + hstep, voffA);
            PG8_WAIT_V(8); PG8_WAIT_L(0); PG8_BAR; PG8_MMA(0, 0, At, B0); PG8_MMA(0, 1, At, B1); PG8_BAR; PG8_SCHED;
            PG8_LDA(At, 0, 1); PG8_STAGE(PG8_SB(0, 0), b2, voffB); PG8_STAGE(PG8_SB(0, 1), b2 + hstep, voffB); PG8_STAGE(PG8_SA(0, 0), a2, voffA);
            PG8_WAIT_V(8); PG8_WAIT_L(0); PG8_BAR; PG8_MMA(1, 0, At, B0); PG8_MMA(1, 1, At, B1); PG8_BAR; PG8_SCHED;
            PG8_LDB(B0, 1, 0); PG8_LDB(B1, 1, 1); PG8_SCHED; PG8_LDA(At, 1, 0); PG8_STAGE(PG8_SA(0, 1), a2 + hstep, voffA);
            PG8_WAIT_V(8); PG8_WAIT_L(0); PG8_BAR; PG8_MMA(0, 0, At, B0); PG8_MMA(0, 1, At, B1); PG8_BAR; PG8_SCHED;
            PG8_LDA(At, 1, 1); PG8_STAGE(PG8_SB(1, 0), b3, voffB); PG8_STAGE(PG8_SB(1, 1), b3 + hstep, voffB); PG8_STAGE(PG8_SA(1, 0), a3, voffA);
            PG8_WAIT_V(8); PG8_WAIT_L(0); PG8_BAR; PG8_MMA(1, 0, At, B0); PG8_MMA(1, 1, At, B1); PG8_BAR; PG8_SCHED;
            } else {
            PG8_LDB(B0, 0, 0); PG8_SCHED; PG8_LDA(At, 0, 0); PG8_STAGE(PG8_SA(1, 1), a1 + hstep, voffA);
            PG8_WAIT_L(8); PG8_BAR; PG8_WAIT_L(0); PG8_MMA(0, 0, At, B0); PG8_BAR; PG8_SCHED;
            PG8_LDB(B1, 0, 1); PG8_STAGE(PG8_SB(0, 0), b2, voffB);
            PG8_BAR; PG8_WAIT_L(0); PG8_MMA(0, 1, At, B1); PG8_BAR;
            PG8_LDA(At, 0, 1); PG8_STAGE(PG8_SA(0, 0), a2, voffA);
            PG8_BAR; PG8_WAIT_L(0); PG8_MMA(1, 0, At, B0); PG8_BAR; PG8_SCHED;
            PG8_STAGE(PG8_SB(0, 1), b2 + hstep, voffB);
            PG8_WAIT_V(6); PG8_BAR; PG8_MMA(1, 1, At, B1); PG8_BAR;
            PG8_LDB(B0, 1, 0); PG8_SCHED; PG8_LDA(At, 1, 0); PG8_STAGE(PG8_SA(0, 1), a2 + hstep, voffA);
            PG8_WAIT_L(8); PG8_BAR; PG8_WAIT_L(0); PG8_MMA(0, 0, At, B0); PG8_BAR; PG8_SCHED;
            PG8_LDB(B1, 1, 1); PG8_STAGE(PG8_SB(1, 0), b3, voffB);
            PG8_BAR; PG8_WAIT_L(0); PG8_MMA(0, 1, At, B1); PG8_BAR;
            PG8_LDA(At, 1, 1); PG8_STAGE(PG8_SA(1, 0), a3, voffA);
            PG8_BAR; PG8_WAIT_L(0); PG8_MMA(1, 0, At, B0); PG8_BAR; PG8_SCHED;
            PG8_STAGE(PG8_SB(1, 1), b3 + hstep, voffB);
            PG8_WAIT_V(6); PG8_BAR; PG8_MMA(1, 1, At, B1); PG8_BAR;
            }
        }
        if constexpr (ALIGN_EPI) { if (wr == 0) PG8_BAR; }
#ifndef REP_EPI
#define REP_EPI 1
#endif
        if constexpr (!Epi::AFTER_DRAIN) { for (int re_ = 0; re_ < (Epi::IDEMPOTENT ? REP_EPI : 1); ++re_) E(acc, cur, wr, wc, fr, fq); S.done(cur); }
        if (!has_next) break;
#pragma unroll
        for (int a = 0; a < 2; ++a)
#pragma unroll
            for (int b = 0; b < 2; ++b)
#pragma unroll
                for (int m = 0; m < 4; ++m)
#pragma unroll
                    for (int n = 0; n < 2; ++n) acc[a][b][m][n] = (f32x4){0.f, 0.f, 0.f, 0.f};
        cur = nxt; cA = nA; cB = nB; ++ui;
        if constexpr (ALIGN_EPI) { if (wr == 1) PG8_BAR; }
    }
    PG8_WAIT_V(0);
    if constexpr (!ALIGN_EPI) { if (wr == 0) PG8_BAR; }
    PG8_BAR;
    if constexpr (Epi::AFTER_DRAIN) { E.fused(acc, cur, wr, wc, fr, fq, lds, wid, lane); S.done(cur); }
#undef PG8_SA
#undef PG8_SB
#undef PG8_STAGE
#undef PG8_LDA
#undef PG8_LDB
#undef PG8_MMA
#undef PG8_WAIT_V
#undef PG8_WAIT_L
#undef PG8_BAR
#undef PG8_SCHED
}
}

#define LAS __attribute__((address_space(3)))
typedef unsigned short bf16_t;
typedef short bf16x8 __attribute__((ext_vector_type(8)));
typedef short s16x4 __attribute__((ext_vector_type(4)));
typedef float f32x4 __attribute__((ext_vector_type(4)));
typedef float f32x16 __attribute__((ext_vector_type(16)));
typedef unsigned u32x4 __attribute__((ext_vector_type(4)));
typedef unsigned u32x2 __attribute__((ext_vector_type(2)));

constexpr int BATCH = 4, SEQ = 4096, DM = 2048, M = BATCH * SEQ, NH = 8;
constexpr int IN_COLS = 8208, NPROJ = 8192;
constexpr size_t PJ_RB = 256 * 2048;
__host__ __device__ __forceinline__ size_t pj2(size_t row, int col) { return ((row >> 6) * 64 + (size_t)(col >> 5)) * 2048 + (row & 63) * 32 + (col & 31); }
__host__ __device__ __forceinline__ size_t pj(size_t row, int col) { return ((row >> 6) * 256 + (size_t)(col >> 5)) * 2048 + (row & 63) * 32 + (col & 31); }
constexpr int C_DAQ = 0, C_DAK = 1024, C_DAV = 2048, C_DAG = 3072, C_GQ = 4096, C_GK = 5120, C_GV = 6144, C_GZ = 7168;
constexpr float RMS_EPS = 1e-6f;
constexpr float LOG2E = 1.4426950408889634f;
constexpr float QSCALE = 0.125f * LOG2E;

constexpr size_t MiB = 1u << 20;
constexpr size_t WS_CTL = 0;
constexpr size_t WS_WIN = 1 * MiB;
constexpr size_t WS_WBA = 65 * MiB;
constexpr size_t WS_WOUT = 66 * MiB;
constexpr size_t WS_XB = 82 * MiB;
constexpr size_t WS_PROJ = 146 * MiB;
constexpr size_t WS_MIXED = 402 * MiB;
constexpr size_t WS_VN = 466 * MiB;
constexpr size_t WS_ROWSQ = 498 * MiB;
constexpr size_t WS_BA = 500 * MiB;
constexpr size_t WS_GB = 501 * MiB;
constexpr size_t WS_END = 502 * MiB;

constexpr int RING_BYTES = 131072;
constexpr int LDSX_OFF = RING_BYTES;
constexpr int LDS_BYTES = 163840;
constexpr int LDS_BARST = 163584;

__device__ __forceinline__ unsigned cvtpk(float lo, float hi) { unsigned r; asm volatile("v_cvt_pk_bf16_f32 %0, %1, %2" : "=v"(r) : "v"(lo), "v"(hi)); return r; }
__device__ __forceinline__ float bf_lo(unsigned w) { return __uint_as_float(w << 16); }
__device__ __forceinline__ float bf_hi(unsigned w) { return __uint_as_float(w & 0xffff0000u); }
template <int K> __device__ __forceinline__ float shx(float v) {
    const int x = __builtin_bit_cast(int, v);
    if constexpr (K == 1) return __builtin_bit_cast(float, __builtin_amdgcn_update_dpp(x, x, 0xB1, 0xF, 0xF, true));
    else if constexpr (K == 2) return __builtin_bit_cast(float, __builtin_amdgcn_update_dpp(x, x, 0x4E, 0xF, 0xF, true));
    else if constexpr (K == 32) { auto rr = __builtin_amdgcn_permlane32_swap((unsigned)x, (unsigned)x, false, false);
        return __builtin_bit_cast(float, (__builtin_amdgcn_mbcnt_hi(-1, 0) != 0) ? rr[0] : rr[1]); }
    else return __builtin_bit_cast(float, __builtin_amdgcn_ds_swizzle(x, (K << 10) | 0x1F));
}
__device__ __forceinline__ float rsum16(float v) {
    int x = __builtin_bit_cast(int, v); v += __builtin_bit_cast(float, __builtin_amdgcn_update_dpp(x, x, 0x128, 0xF, 0xF, true));
    x = __builtin_bit_cast(int, v); v += __builtin_bit_cast(float, __builtin_amdgcn_update_dpp(x, x, 0x124, 0xF, 0xF, true));
    x = __builtin_bit_cast(int, v); v += __builtin_bit_cast(float, __builtin_amdgcn_update_dpp(x, x, 0x4E, 0xF, 0xF, true));
    x = __builtin_bit_cast(int, v); v += __builtin_bit_cast(float, __builtin_amdgcn_update_dpp(x, x, 0xB1, 0xF, 0xF, true));
    return v; }
__device__ __forceinline__ float sum32(float v) { auto rr = __builtin_amdgcn_permlane32_swap(__float_as_uint(v), __float_as_uint(v), false, false); return __uint_as_float(rr[0]) + __uint_as_float(rr[1]); }
__device__ __forceinline__ float wave_sum(float v) { v += shx<1>(v); v += shx<2>(v); v += shx<4>(v); v += shx<8>(v); v += shx<16>(v); return sum32(v); }
__device__ __forceinline__ float frcp(float x) { return __builtin_amdgcn_rcpf(x); }
__device__ __forceinline__ float frsq(float x) { return __builtin_amdgcn_rsqf(x); }
__device__ __forceinline__ float silu_f(float x) { return x * frcp(1.f + __expf(-x)); }

#ifndef REP_P0
#define REP_P0 1
#endif
#ifndef REP_P1
#define REP_P1 1
#endif
#ifndef REP_CONV
#define REP_CONV 1
#endif
#ifndef REP_ATT
#define REP_ATT 1
#endif
#ifndef REP_SCAN
#define REP_SCAN 1
#endif
#ifndef REP_P3
#define REP_P3 1
#endif
#ifndef PG8_SP2_ALL
#define PG8_SP2_ALL true
#endif
#ifndef PG8_ALIGN_P1
#define PG8_ALIGN_P1 true
#endif
struct Args { const float* in[15]; float* out; unsigned char* ws; };

struct Ctx {
    int tid, lane, wave, bid, G;
    const float *x, *norm_w, *w_in, *w_out, *lq1, *lk1, *lq2, *lk2, *subln_w, *rel_bias, *conv_w, *a_log, *dt_bias, *gdn_norm_w, *final_w;
    float* out; unsigned char* ws;
};

__device__ __forceinline__ int fresh_tid(int wave) { int l; asm volatile("v_mbcnt_lo_u32_b32 %0, -1, 0\n\tv_mbcnt_hi_u32_b32 %0, -1, %0" : "=v"(l)); return wave * 64 + l; }
__device__ __forceinline__ void relaunder(Ctx& F) { const int t = fresh_tid(F.wave); F.tid = t; F.lane = t & 63; }

__device__ __forceinline__ void p0_transpose_item(const float* W, int K, int N, const float* kscale, bf16_t* WT, int Nmain, bf16_t* WT2, LAS float* scr, int item, int lane) {
    const int nblk = (N + 63) / 64, kb = item / nblk, nb = item % nblk, k0 = 64 * kb, n0 = 64 * nb;
    const int nn = n0 + (lane & 15) * 4;
    f32x4 v[16];
#pragma unroll
    for (int i = 0; i < 16; ++i) { const int kk = 4 * i + (lane >> 4); v[i] = (nn < N) ? *(const f32x4*)(W + (size_t)(k0 + kk) * N + nn) : (f32x4){0.f, 0.f, 0.f, 0.f}; }
#pragma unroll
    for (int i = 0; i < 16; ++i) { const int kk = 4 * i + (lane >> 4); const float ks = kscale ? kscale[k0 + kk] : 1.f; LAS float* d = scr + kk * 65 + (lane & 15) * 4;
        d[0] = v[i][0] * ks; d[1] = v[i][1] * ks; d[2] = v[i][2] * ks; d[3] = v[i][3] * ks; }
    asm volatile("s_waitcnt lgkmcnt(0)" ::: "memory");
    const int c = lane & 7;
#pragma unroll
    for (int j = 0; j < 8; ++j) { const int n = (lane >> 3) + 8 * j; const LAS float* s = scr + (8 * c) * 65 + n;
        u32x4 o; o.x = cvtpk(s[0 * 65], s[1 * 65]); o.y = cvtpk(s[2 * 65], s[3 * 65]); o.z = cvtpk(s[4 * 65], s[5 * 65]); o.w = cvtpk(s[6 * 65], s[7 * 65]);
        const int ng = n0 + n;
        if (ng < Nmain) *(u32x4*)(WT + (((size_t)(ng >> 6) * (K / 32) + ((k0 + 8 * c) >> 5)) * 2048 + (ng & 63) * 32 + ((k0 + 8 * c) & 31))) = o;
        else if (ng < N) *(u32x4*)(WT2 + (size_t)(ng - Nmain) * K + k0 + 8 * c) = o; }
    asm volatile("s_waitcnt lgkmcnt(0)" ::: "memory");
}
constexpr int P0_I_IN = (DM / 64) * ((IN_COLS + 63) / 64), P0_I_OUT = (DM / 64) * (DM / 64), P0_LAYER_ITEMS = P0_I_IN + P0_I_OUT;
__device__ __forceinline__ void p0_weight_item(Ctx& F, LAS float* scr, int l, int r) {
    if (r < P0_I_IN) p0_transpose_item(F.w_in + (size_t)l * DM * IN_COLS, DM, IN_COLS, F.norm_w + l * DM, (bf16_t*)(F.ws + WS_WIN) + (size_t)l * NPROJ * DM, NPROJ,
                                       (bf16_t*)(F.ws + WS_WBA) + (size_t)l * 16 * DM, scr, r, F.lane);
    else p0_transpose_item(F.w_out + (size_t)l * DM * DM, DM, DM, nullptr, (bf16_t*)(F.ws + WS_WOUT) + (size_t)l * DM * DM, DM, nullptr, scr, r - P0_I_IN, F.lane);
}
__device__ __forceinline__ void p0_prologue(Ctx& F, LAS unsigned char* lds) {
    LAS float* scr = (LAS float*)(lds + F.wave * 17408);
    const int gw = F.bid * 8 + F.wave, NGW = F.G * 8;
    for (int it = gw; it < P0_LAYER_ITEMS; it += NGW) p0_weight_item(F, scr, 0, it);
    bf16_t* XB = (bf16_t*)(F.ws + WS_XB); float* RQ = (float*)(F.ws + WS_ROWSQ);
    for (int m = gw; m < M; m += NGW) {
        const f32x4* xr = (const f32x4*)(F.x + (size_t)m * DM) + F.lane; float ss = 0.f;
        bf16_t* xbrow = XB + pj2((size_t)m, 4 * F.lane);
        f32x4 xv8[8];
#pragma unroll
        for (int j = 0; j < 8; ++j) xv8[j] = xr[64 * j];
#pragma unroll
        for (int j = 0; j < 8; ++j) { const f32x4 v = xv8[j]; ss += (v[0] * v[0] + v[1] * v[1]) + (v[2] * v[2] + v[3] * v[3]); u32x2 w; w.x = cvtpk(v[0], v[1]); w.y = cvtpk(v[2], v[3]); *(u32x2*)(xbrow + (size_t)j * 8 * 2048) = w; }
        ss = wave_sum(ss);
        if (F.lane < 32) RQ[(size_t)m * 32 + F.lane] = (F.lane == 0) ? ss : 0.f;
    }
}

__device__ __forceinline__ void rstd_table(Ctx& F, LAS float* tab, int row0, int nrows) {
    const float* RQ = (const float*)(F.ws + WS_ROWSQ);
    const int r = F.tid >> 1, hf = F.tid & 1;
    float s = 0.f;
    if (r < nrows) { const f32x4* p = (const f32x4*)(RQ + (size_t)(row0 + r) * 32 + hf * 16);
#pragma unroll
        for (int i = 0; i < 4; ++i) { const f32x4 v = p[i]; s += (v[0] + v[1]) + (v[2] + v[3]); } }
    s += shx<1>(s);
    if (r < nrows && hf == 0) tab[r] = frsq(s * (1.0f / DM) + RMS_EPS);
}

__device__ __forceinline__ void ba_job(Ctx& F, LAS unsigned char* lds, int layer) {
    const bf16_t* XB = (const bf16_t*)(F.ws + WS_XB); const bf16_t* WB = (const bf16_t*)(F.ws + WS_WBA) + (size_t)layer * 16 * DM;
    float* BA = (float*)(F.ws + WS_BA);
    const int row0 = F.bid * 64; if (row0 >= M) return;
    LAS float* rs = (LAS float*)(lds + 65536);
    const int fr = F.lane & 15, fq = F.lane >> 4, k0 = F.wave * 256;
    bf16x8 bfr[8], afr[8][4];
#pragma unroll
    for (int s = 0; s < 8; ++s) { const int k = k0 + s * 32 + fq * 8;
        bfr[s] = *(const bf16x8*)(WB + (size_t)fr * DM + k);
#pragma unroll
        for (int rb = 0; rb < 4; ++rb) afr[s][rb] = *(const bf16x8*)(XB + pj2((size_t)(row0 + rb * 16 + fr), k)); }
    asm volatile("" ::: "memory");
    rstd_table(F, rs, row0, 64);
    f32x4 acc[4] = {};
#pragma unroll
    for (int s = 0; s < 8; ++s)
#pragma unroll
        for (int rb = 0; rb < 4; ++rb) acc[rb] = __builtin_amdgcn_mfma_f32_16x16x32_bf16(afr[s][rb], bfr[s], acc[rb], 0, 0, 0);
    LAS float* red = (LAS float*)lds + F.wave * 1024;
#pragma unroll
    for (int rb = 0; rb < 4; ++rb)
#pragma unroll
        for (int i = 0; i < 4; ++i) red[(rb * 16 + fq * 4 + i) * 16 + fr] = acc[rb][i];
    __syncthreads();
    for (int e = F.tid; e < 1024; e += 512) { float s = 0.f;
#pragma unroll
        for (int w = 0; w < 8; ++w) s += ((LAS float*)lds)[w * 1024 + e];
        BA[(size_t)row0 * 16 + e] = s * rs[e >> 4]; }
    __syncthreads();
}

namespace att {
constexpr int QB = 256, KVBLK = 64;
constexpr int SHM_V = 16384, SHM_K = 16384;
constexpr int OFF_V = 0, OFF_K = SHM_V, BUF2 = SHM_V + SHM_K, OFF_Q = 2 * BUF2;
constexpr int OFF_TAB = LDSX_OFF + 4096, OFF_WS = LDSX_OFF + 4096 + 2048;
constexpr int OFF_V2 = LDSX_OFF + 8192;
constexpr float SM_THR = 6.0f;
constexpr int NMAXT = 255;
#define KSWZ(row, colB) ((row) * 256 + ((colB) ^ (((row) & 7) << 4)))
#define SBAR() __builtin_amdgcn_sched_barrier(0)
__device__ __forceinline__ int v_st(int k, int c) { const int kk = (k & ~0xC) | ((k & 4) << 1) | ((k & 8) >> 1); return ((kk >> 3) * 4 + (c >> 5)) * 512 + ((kk & 7) * 32 + (c & 31)) * 2; }
__device__ __forceinline__ int v_rd_base(int lane) { return ((lane & 3) << 3) | (((lane >> 2) & 3) << 6) | (((lane >> 4) & 1) << 5) | (((lane >> 5) & 1) << 8); }
constexpr int v_rd_off(int d0, int ks, int half) { return d0 * 512 + ks * 4096 + half * 2048; }
__device__ __forceinline__ int crow(int r, int hi) { return (r & 3) + 8 * (r >> 2) + 4 * hi; }

__constant__ const unsigned char T5_BUCKET[113] = {0, 1, 2, 3, 4, 5, 6, 7, 8, 9, 10, 11, 12, 13, 14, 15, 16, 16, 16, 17, 17, 18, 18, 18, 19, 19, 19, 20, 20, 20, 20, 21, 21, 21, 21, 22, 22, 22, 22, 22, 23, 23, 23, 23, 23, 23,
    24, 24, 24, 24, 24, 24, 25, 25, 25, 25, 25, 25, 25, 26, 26, 26, 26, 26, 26, 26, 26, 27, 27, 27, 27, 27, 27, 27, 27, 27, 27, 28, 28, 28, 28, 28, 28, 28, 28, 28, 28, 29, 29, 29, 29, 29, 29, 29, 29, 29, 29, 29, 29,
    30, 30, 30, 30, 30, 30, 30, 30, 30, 30, 30, 30, 30, 30};

template <int KOFF> __device__ __forceinline__ void qkt(f32x16& p0, f32x16& p1, const unsigned* ka, const unsigned* qa, int mp) {
    p0 = f32x16{}; p1 = f32x16{};
#pragma unroll
    for (int dd = 0; dd < 4; ++dd) {
        const LAS char* a = (const LAS char*)(uintptr_t)ka[dd] + mp * 128 + KOFF; const LAS char* q = (const LAS char*)(uintptr_t)qa[dd] + mp * 128;
        const bf16x8 b0 = *reinterpret_cast<const LAS bf16x8*>(a);
        const bf16x8 b1 = *reinterpret_cast<const LAS bf16x8*>(a + 32 * 256);
        const bf16x8 qf = *reinterpret_cast<const LAS bf16x8*>(q);
        p0 = __builtin_amdgcn_mfma_f32_32x32x16_bf16(b0, qf, p0, 0, 0, 0);
        p1 = __builtin_amdgcn_mfma_f32_32x32x16_bf16(b1, qf, p1, 0, 0, 0); }
}
template <int VOFF> __device__ __forceinline__ void pv_tile(f32x16* o, int vb0, bf16x8 pa0, bf16x8 pa1, bf16x8 pa2, bf16x8 pa3) {
#define TRRD(dst, off) asm volatile("ds_read_b64_tr_b16 %0, %1 offset:%2" : "=&v"(dst) : "v"(vb0), "i"(off) : "memory")
#define PV_D0(d0) do { s16x4 l0, l1, l2, l3, h0, h1, h2, h3; constexpr int b_ = VOFF + v_rd_off(d0, 0, 0); \
        TRRD(l0, b_); TRRD(h0, b_ + 2048); TRRD(l1, b_ + 4096); TRRD(h1, b_ + 6144); TRRD(l2, b_ + 8192); TRRD(h2, b_ + 10240); TRRD(l3, b_ + 12288); TRRD(h3, b_ + 14336); \
        asm volatile("s_waitcnt lgkmcnt(0)" ::: "memory"); SBAR(); \
        o[d0] = __builtin_amdgcn_mfma_f32_32x32x16_bf16(pa0, (bf16x8){l0[0], l0[1], l0[2], l0[3], h0[0], h0[1], h0[2], h0[3]}, o[d0], 0, 0, 0); \
        o[d0] = __builtin_amdgcn_mfma_f32_32x32x16_bf16(pa1, (bf16x8){l1[0], l1[1], l1[2], l1[3], h1[0], h1[1], h1[2], h1[3]}, o[d0], 0, 0, 0); \
        o[d0] = __builtin_amdgcn_mfma_f32_32x32x16_bf16(pa2, (bf16x8){l2[0], l2[1], l2[2], l2[3], h2[0], h2[1], h2[2], h2[3]}, o[d0], 0, 0, 0); \
        o[d0] = __builtin_amdgcn_mfma_f32_32x32x16_bf16(pa3, (bf16x8){l3[0], l3[1], l3[2], l3[3], h3[0], h3[1], h3[2], h3[3]}, o[d0], 0, 0, 0); } while (0)
    PV_D0(0); PV_D0(1); PV_D0(2); PV_D0(3);
#undef PV_D0
#undef TRRD
}
__device__ __forceinline__ void softmax_tile(f32x16& p0, f32x16& p1, float& m_reg, float& l_reg, f32x16* o, float* al_l, int r32, int hi,
                                             bf16x8& pa0, bf16x8& pa1, bf16x8& pa2, bf16x8& pa3) {
    float pmax = p0[0];
#pragma unroll
    for (int r = 1; r < 16; ++r) pmax = fmaxf(pmax, p0[r]);
#pragma unroll
    for (int r = 0; r < 16; ++r) pmax = fmaxf(pmax, p1[r]);
    { auto rr = __builtin_amdgcn_permlane32_swap(__float_as_uint(pmax), __float_as_uint(pmax), false, false);
      pmax = fmaxf(__uint_as_float(rr[0]), __uint_as_float(rr[1])); }
    const float mn = fmaxf(m_reg, pmax);
    if (__any(pmax > m_reg + SM_THR)) {
        const float alpha = __builtin_amdgcn_exp2f(m_reg - mn);
        l_reg *= alpha; m_reg = mn;
        if (hi == 0) al_l[r32] = alpha;
        asm volatile("s_waitcnt lgkmcnt(0)" ::: "memory");
#pragma unroll
        for (int d_ = 0; d_ < 4; ++d_)
#pragma unroll
            for (int r = 0; r < 16; ++r) o[d_][r] *= al_l[crow(r, hi)];
    }
#pragma unroll
    for (int r = 0; r < 16; ++r) { p0[r] = __builtin_amdgcn_exp2f(p0[r] - m_reg); p1[r] = __builtin_amdgcn_exp2f(p1[r] - m_reg); }
    float ps = 0.f;
#pragma unroll
    for (int r = 0; r < 16; ++r) ps += p0[r];
#pragma unroll
    for (int r = 0; r < 16; ++r) ps += p1[r];
    { auto rr = __builtin_amdgcn_permlane32_swap(__float_as_uint(ps), __float_as_uint(ps), false, false);
      ps = __uint_as_float(rr[0]) + __uint_as_float(rr[1]); }
    l_reg += ps;
#define PK4(P, B_, OUT) do { unsigned a0 = cvtpk(P[B_+0], P[B_+1]), a1 = cvtpk(P[B_+2], P[B_+3]); \
        unsigned b0 = cvtpk(P[B_+4], P[B_+5]), b1 = cvtpk(P[B_+6], P[B_+7]); \
        auto r0 = __builtin_amdgcn_permlane32_swap(a0, b0, false, false); auto r1 = __builtin_amdgcn_permlane32_swap(a1, b1, false, false); \
        u32x4 w = {r0[0], r1[0], r0[1], r1[1]}; OUT = *reinterpret_cast<bf16x8*>(&w); } while (0)
    PK4(p0, 0, pa0); PK4(p0, 8, pa1); PK4(p1, 0, pa2); PK4(p1, 8, pa3);
#undef PK4
}

template <bool ISY> __device__ __forceinline__ void attn_unit(Ctx& F, char* lds, int layer, int b, int h, int qb, float lam, float one_minus_li, unsigned* wqp, volatile LAS unsigned* wqlp) {
    const int tid_ = fresh_tid(F.wave);
    const int tid = tid_, wid = F.wave, lane = tid & 63, r32 = lane & 31, hi = lane >> 5;
    const bf16_t* PROJ = (const bf16_t*)(F.ws + WS_PROJ); bf16_t* MIXED = (bf16_t*)(F.ws + WS_MIXED);
    const long rowbase = (long)b * SEQ; const int q0 = qb * QB;
    char* V_lds = lds + OFF_V; char* K_lds = lds + OFF_K;
    float* tab = (float*)(lds + OFF_TAB); float* al_l = (float*)(lds + OFF_WS) + wid * 64;
    char* Qw_lds = lds + OFF_Q + wid * 8192;
    const int sr = tid >> 4, sc = (tid & 15) * 8;
    const bf16_t* Kg = PROJ + pj((size_t)rowbase + sr, C_DAK + h * 128 + sc);
    const bf16_t* Vg = PROJ + pj((size_t)rowbase + sr, C_DAV + h * 128 + sc);
    bf16x8 st_k0, st_k1, st_v0, st_v1;
    { const int nb_ = NMAXT - tid;
      const float b31 = F.rel_bias[31 * NH + h];
      const float bv_ = (nb_ >= 0 && nb_ < 113) ? F.rel_bias[(int)T5_BUCKET[nb_] * NH + h] : b31;
      bf16x8 qv_[8];
      const size_t qrow0 = (size_t)(rowbase + q0 + wid * 32);
#pragma unroll
      for (int i = 0; i < 8; ++i) { const int e = i * 64 + lane, row = e >> 4, c8 = (e & 15) * 8; qv_[i] = *reinterpret_cast<const bf16x8*>(PROJ + pj(qrow0 + row, C_DAQ + h * 128 + c8)); }
      st_k0 = *(const bf16x8*)(Kg); st_k1 = *(const bf16x8*)(Kg + (size_t)1024); st_v0 = *(const bf16x8*)(Vg); st_v1 = *(const bf16x8*)(Vg + (size_t)1024);
      asm volatile("" ::: "memory");
      tab[tid] = (nb_ < 0) ? -__builtin_inff() : (bv_ - b31) * LOG2E;
#pragma unroll
      for (int i = 0; i < 8; ++i) { const int e = i * 64 + lane, row = e >> 4, c8 = (e & 15) * 8; *(bf16x8*)(Qw_lds + KSWZ(row, c8 * 2)) = qv_[i]; } }
    const int vst0 = v_st(sr, sc), vst1 = v_st(32 + sr, sc), kws = KSWZ(sr, sc * 2);
    const int vb0 = (int)(uintptr_t)V_lds + v_rd_base(lane);
    unsigned ka[4], qa[4];
#pragma unroll
    for (int dd = 0; dd < 4; ++dd) { const unsigned o_ = (unsigned)KSWZ(r32, (dd * 16 + hi * 8) * 2); ka[dd] = (unsigned)(uintptr_t)K_lds + o_; qa[dd] = (unsigned)(uintptr_t)Qw_lds + o_; }
    const int NT = (q0 + QB) / KVBLK;
    const int qlo = q0 + wid * 32;
    float m1 = -1e30f, l1 = 0.f, m2 = -1e30f, l2 = 0.f;
    f32x16 o1[4] = {}, o2[4] = {};
#define SLOAD(t) do { const size_t o_ = (size_t)(t) * PJ_RB; st_k0 = *(const bf16x8*)(Kg + o_); st_k1 = *(const bf16x8*)(Kg + o_ + (size_t)1024); \
                      st_v0 = *(const bf16x8*)(Vg + o_); st_v1 = *(const bf16x8*)(Vg + o_ + (size_t)1024); } while (0)
#define SWRITE(BO, VO) do { *(bf16x8*)(K_lds + (BO) + kws) = st_k0; *(bf16x8*)(K_lds + (BO) + kws + 32 * 256) = st_k1; *(bf16x8*)(lds + (VO) + vst0) = st_v0; *(bf16x8*)(lds + (VO) + vst1) = st_v1; } while (0)
    constexpr bool isY = ISY;
    bool pend = false;
    int vo_prev = OFF_V2, vo_cur = 0, vo_nxt = BUF2;
    bf16x8 pp0, pp1, pp2, pp3;
#define ASTEP(t, CUR, NXT) do { \
        if ((t) + 1 < NT) { SWRITE((NXT) * BUF2, vo_nxt); } \
        if ((t) + 2 < NT) { SLOAD((t) + 2); } \
        if (isY && pend) { asm volatile("" ::: "memory"); pv_tile<0>(o2, vb0 + vo_prev, pp0, pp1, pp2, pp3); pend = false; SBAR(); } \
        const int kb = (t) * KVBLK; \
        if (kb <= qlo + 31) {                                \
        const bool band = (qlo - kb - 63) < 113;             \
        const int jb = NMAXT - (qlo + r32 - kb) + 4 * hi;    \
        { f32x16 p0, p1, s0, s1; bf16x8 pa0, pa1, pa2, pa3; \
            asm volatile("" ::: "memory"); \
            qkt<(CUR) * BUF2>(p0, p1, ka, qa, 0); \
            asm volatile("" ::: "memory"); \
            if (band) { _Pragma("unroll") for (int r = 0; r < 16; ++r) { const int c = (r & 3) + 8 * (r >> 2); p0[r] += tab[jb + c]; p1[r] += tab[jb + 32 + c]; } } \
            asm volatile("" ::: "memory"); \
            softmax_tile(p0, p1, m1, l1, o1, al_l, r32, hi, pa0, pa1, pa2, pa3); SBAR(); \
            qkt<(CUR) * BUF2>(s0, s1, ka, qa, 1); SBAR(); \
            pv_tile<0>(o1, vb0 + vo_cur, pa0, pa1, pa2, pa3); SBAR(); \
            if (band) { _Pragma("unroll") for (int r = 0; r < 16; ++r) { const int c = (r & 3) + 8 * (r >> 2); s0[r] += tab[jb + c]; s1[r] += tab[jb + 32 + c]; } } \
            asm volatile("" ::: "memory"); \
            softmax_tile(s0, s1, m2, l2, o2, al_l, r32, hi, pp0, pp1, pp2, pp3); SBAR(); \
            if (isY) pend = true; else pv_tile<0>(o2, vb0 + vo_cur, pp0, pp1, pp2, pp3); \
        } } \
        asm volatile("s_waitcnt lgkmcnt(0)" ::: "memory"); __builtin_amdgcn_s_barrier(); asm volatile("" ::: "memory");        \
        { const int tmp_ = vo_prev; vo_prev = vo_cur; vo_cur = vo_nxt; vo_nxt = tmp_; } } while (0)
    SWRITE(0, 0); SLOAD(1);
    __syncthreads();
#pragma unroll 1
    for (int t = 0; t < NT; t += 2) { ASTEP(t, 0, 1); ASTEP(t + 1, 1, 0); }
    if (isY && pend) { asm volatile("" ::: "memory"); pv_tile<0>(o2, vb0 + vo_prev, pp0, pp1, pp2, pp3); }
#undef SLOAD
#undef SWRITE
#undef ASTEP
    __syncthreads();
    unsigned nxt_ = 0u; if (tid == 0) nxt_ = __hip_atomic_fetch_add(wqp, 1u, __ATOMIC_RELAXED, __HIP_MEMORY_SCOPE_AGENT);
    { float* stg = (float*)(lds + wid * 16384);
      const int row = lane >> 1, hf = lane & 1;
      const size_t grow = (size_t)(rowbase + q0 + wid * 32 + row);
      const bf16_t* gp = PROJ + pj(grow, C_DAG + h * 128 + hf * 64);
      u32x4 g8[8];
#pragma unroll
      for (int i = 0; i < 8; ++i) g8[i] = *(const u32x4*)(gp + (i >> 2) * 2048 + (i & 3) * 8);
      asm volatile("" ::: "memory");
      if (hi == 0) { al_l[r32] = frcp(l1); al_l[32 + r32] = lam * frcp(l2); }
      asm volatile("s_waitcnt lgkmcnt(0)" ::: "memory");
#pragma unroll
      for (int r = 0; r < 16; ++r) { const int orow = crow(r, hi); const float a = al_l[orow], bb = al_l[32 + orow];
#pragma unroll
          for (int d0 = 0; d0 < 4; ++d0) stg[orow * 128 + d0 * 32 + r32] = o1[d0][r] * a - o2[d0][r] * bb; }
      asm volatile("s_waitcnt lgkmcnt(0)" ::: "memory");
      const f32x4* sp = (const f32x4*)(stg + row * 128 + hf * 64);
      float ss = 0.f;
#pragma unroll
      for (int i = 0; i < 16; ++i) { const f32x4 t4 = sp[i]; ss += (t4[0] * t4[0] + t4[1] * t4[1]) + (t4[2] * t4[2] + t4[3] * t4[3]); }
      ss += shx<1>(ss);
      const float rs = one_minus_li * frsq(ss * (1.0f / 128.0f) + RMS_EPS);
      bf16_t* op = MIXED + pj2(grow, h * 128 + hf * 64);
      const float* sw = F.subln_w + layer * 128 + hf * 64;
#pragma unroll 2
      for (int i = 0; i < 8; ++i) { const u32x4 g = g8[i]; const f32x4 w0 = *(const f32x4*)(sw + i * 8), w1 = *(const f32x4*)(sw + i * 8 + 4);
          const f32x4 a = sp[2 * i], c = sp[2 * i + 1]; u32x4 o;
          o.x = cvtpk(a[0] * rs * w0[0] * bf_lo(g.x), a[1] * rs * w0[1] * bf_hi(g.x));
          o.y = cvtpk(a[2] * rs * w0[2] * bf_lo(g.y), a[3] * rs * w0[3] * bf_hi(g.y));
          o.z = cvtpk(c[0] * rs * w1[0] * bf_lo(g.z), c[1] * rs * w1[1] * bf_hi(g.z));
          o.w = cvtpk(c[2] * rs * w1[2] * bf_lo(g.w), c[3] * rs * w1[3] * bf_hi(g.w));
          *(u32x4*)(op + (i >> 2) * 2048 + (i & 3) * 8) = o; }
    }
    if (tid == 0) wqlp[0] = nxt_;
    __syncthreads();
}

#undef SBAR
}

namespace gdn {
constexpr int WAVE_LDS = 18432;
constexpr int LT_PITCH = 144;
__host__ __device__ constexpr int ro4(int i) { return i == 0 ? 0 : 4 * ((((i - 1) / 4) + 1) * (2 * ((i - 1) / 4) + (i - 4 * ((i - 1) / 4)) - 1)); }
using att::v_st; using att::v_rd_base; using att::v_rd_off; using att::crow;

#define MKRS(p) __builtin_amdgcn_make_buffer_rsrc((void*)(p), 0, 0x02000000, 0x00020000)
typedef unsigned v4u_t __attribute__((__vector_size__(16)));
__device__ __forceinline__ u32x4 bld128(__amdgpu_buffer_rsrc_t r, unsigned vo, unsigned so) { return __builtin_bit_cast(u32x4, __builtin_amdgcn_raw_buffer_load_b128(r, vo, so, 0)); }
__device__ __forceinline__ void bst128(u32x4 v, __amdgpu_buffer_rsrc_t r, unsigned vo, unsigned so) { __builtin_amdgcn_raw_buffer_store_b128(__builtin_bit_cast(v4u_t, v), r, vo, so, 0); }
__device__ __forceinline__ bf16_t* wbuf(Ctx& F) { return (bf16_t*)((char*)F.out + 64 * MiB); }
__device__ __forceinline__ bf16_t* qkbuf(Ctx& F) { return (bf16_t*)((char*)F.out + 96 * MiB); }
__device__ __forceinline__ void chunk_prep(Ctx& F, char* wl, int layer, int item) {
    const int tid_ = fresh_tid(F.wave);
    const int lane = tid_ & 63, r32 = lane & 31, hi = lane >> 5;
    const int n = item & 63, bh = item >> 6, b = bh >> 3, h = bh & 7;
    const size_t m0 = (size_t)b * SEQ + (size_t)n * 64;
    bf16_t* QN = (bf16_t*)F.out; bf16_t* KN = (bf16_t*)((char*)F.out + 32 * MiB); bf16_t* VN = (bf16_t*)(F.ws + WS_VN);
    float* GB = (float*)(F.ws + WS_GB); const float* BA = (const float*)(F.ws + WS_BA); const bf16_t* PROJ = (const bf16_t*)(F.ws + WS_PROJ);
    const __amdgpu_buffer_rsrc_t rsQ = MKRS(QN + m0 * 1024 + h * 128), rsK = MKRS(KN + m0 * 1024 + h * 128), rsV = MKRS(VN + m0 * 1024 + h * 128);
    const unsigned offS = (unsigned)(((lane >> 4) * 1024 + (lane & 15) * 8) * 2);
    float* Lp = (float*)wl; char* Tl = wl; char* stg = wl + 9216; float* Gt = (float*)(wl + 17408); float* Bt = Gt + 64;
    const int g4 = lane >> 4, c8 = (lane & 15) * 8;
    const bool zero_hist = (n == 0) && (g4 == 0);
    const bf16_t* src0 = PROJ + pj(m0 + 16 * g4, C_GQ + h * 128 + c8);
    const bf16_t* hsrc0 = (g4 == 0) ? (src0 - PJ_RB + 64 * 32) : src0;
    const float* cw0 = F.conv_w + (size_t)layer * 4 * 3072 + h * 128 + c8;
    typedef float f32x2_t __attribute__((ext_vector_type(2)));
    u32x4 rawA[8], rawB[8], hal[3]; f32x2_t wA[4][4], wB[4][4];
#define UNPK(dstv, u) do { dstv[0] = (f32x2_t){bf_lo(u.x), bf_hi(u.x)}; dstv[1] = (f32x2_t){bf_lo(u.y), bf_hi(u.y)}; dstv[2] = (f32x2_t){bf_lo(u.z), bf_hi(u.z)}; dstv[3] = (f32x2_t){bf_lo(u.w), bf_hi(u.w)}; } while (0)
#define CLOAD(t, R, blk) do { _Pragma("unroll") for (int j_ = 0; j_ < 8; ++j_) R[j_] = *(const u32x4*)(src0 + (t) * 32 * 2048 + ((blk) * 8 + j_) * 32); } while (0)
#define CLOADH(t) do { hal[0] = *(const u32x4*)(hsrc0 + (t) * 32 * 2048 - 1 * 32); hal[1] = *(const u32x4*)(hsrc0 + (t) * 32 * 2048 - 2 * 32); hal[2] = *(const u32x4*)(hsrc0 + (t) * 32 * 2048 - 3 * 32); } while (0)
#define CLOADW(t, W) do { _Pragma("unroll") for (int j = 0; j < 4; ++j) { const f32x4 a = *(const f32x4*)(cw0 + j * 3072 + (t) * 1024), bb = *(const f32x4*)(cw0 + j * 3072 + (t) * 1024 + 4); \
          W[j][0] = (f32x2_t){a[0], a[1]}; W[j][1] = (f32x2_t){a[2], a[3]}; W[j][2] = (f32x2_t){bb[0], bb[1]}; W[j][3] = (f32x2_t){bb[2], bb[3]}; } } while (0)
#define CFENCE() asm volatile("" ::: "memory")
    CLOADH(0); CLOAD(0, rawA, 0); CLOAD(0, rawB, 1); CLOADW(0, wA);
    CFENCE();
    { const float braw = BA[(m0 + lane) * 16 + h], araw = BA[(m0 + lane) * 16 + 8 + h] + F.dt_bias[layer * NH + h];
      const float sp = fmaxf(araw, 0.f) + __logf(1.f + __expf(-fabsf(araw)));
      const float g = -__expf(F.a_log[layer * NH + h]) * sp, beta = frcp(1.f + __expf(-braw));
      Gt[lane] = g; asm volatile("s_waitcnt lgkmcnt(0)" ::: "memory");
      float Gc = 0.f;
#pragma unroll 8
      for (int m = 0; m < 64; ++m) { const float gm = Gt[m]; Gc += (m <= lane) ? gm : 0.f; }
      asm volatile("s_waitcnt lgkmcnt(0)" ::: "memory");
      Gt[lane] = Gc; Bt[lane] = beta; GB[(m0 + lane) * 16 + h] = Gc;
      asm volatile("s_waitcnt lgkmcnt(0)" ::: "memory"); }
    f32x2_t x1[4], x2[4], x3[4];
    {
#define CINIT() do { UNPK(x1, hal[0]); UNPK(x2, hal[1]); UNPK(x3, hal[2]); \
          _Pragma("unroll") for (int i = 0; i < 4; ++i) { x1[i] = zero_hist ? (f32x2_t){0.f, 0.f} : x1[i]; x2[i] = zero_hist ? (f32x2_t){0.f, 0.f} : x2[i]; x3[i] = zero_hist ? (f32x2_t){0.f, 0.f} : x3[i]; } } while (0)
#define CROWS(t, R, blk, W) do { bf16_t* dst_ = (((t) == 0) ? QN : ((t) == 1) ? KN : VN) + (m0 + 16 * g4 + (blk) * 8) * 1024 + h * 128 + c8; \
          _Pragma("unroll") for (int j_ = 0; j_ < 8; ++j_) { f32x2_t x0[4]; UNPK(x0, R[j_]); f32x2_t y[4]; f32x2_t ss2 = {0.f, 0.f}; \
          _Pragma("unroll") for (int i = 0; i < 4; ++i) { f32x2_t a = W[0][i] * x3[i]; a = __builtin_elementwise_fma(W[1][i], x2[i], a); a = __builtin_elementwise_fma(W[2][i], x1[i], a); a = __builtin_elementwise_fma(W[3][i], x0[i], a); \
              f32x2_t e = a * (f32x2_t){-LOG2E, -LOG2E}; e = (f32x2_t){__builtin_amdgcn_exp2f(e.x), __builtin_amdgcn_exp2f(e.y)} + (f32x2_t){1.f, 1.f}; \
              a = a * (f32x2_t){__builtin_amdgcn_rcpf(e.x), __builtin_amdgcn_rcpf(e.y)}; y[i] = a; ss2 = __builtin_elementwise_fma(a, a, ss2); x3[i] = x2[i]; x2[i] = x1[i]; x1[i] = x0[i]; } \
          float ss = rsum16(ss2.x + ss2.y); \
          const float sc_ = ((t) < 2) ? (((t) == 0) ? 0.08838834764831845f : 1.f) * frsq(ss + RMS_EPS) : 1.f; \
          const f32x2_t sc2 = {sc_, sc_}; const f32x2_t y0 = y[0] * sc2, y1 = y[1] * sc2, y2 = y[2] * sc2, y3 = y[3] * sc2; \
          u32x4 o; o.x = cvtpk(y0.x, y0.y); o.y = cvtpk(y1.x, y1.y); o.z = cvtpk(y2.x, y2.y); o.w = cvtpk(y3.x, y3.y); \
          *(u32x4*)(dst_ + (size_t)j_ * 1024) = o; } } while (0)
      CINIT();
      CROWS(0, rawA, 0, wA);
      CFENCE(); CLOADH(1); CLOADW(1, wB); CLOAD(1, rawA, 0); CFENCE();
      CROWS(0, rawB, 1, wA);
      CFENCE(); CLOAD(1, rawB, 1); CFENCE();
      CINIT();
      CROWS(1, rawA, 0, wB);
      CROWS(1, rawB, 1, wB);
      asm volatile("s_waitcnt vmcnt(0)" ::: "memory"); }
    bf16x8 kf[2][8], qf[2][8];
    { const bf16_t* kp = KN + (m0 + r32) * 1024 + h * 128 + hi * 8;
#pragma unroll
      for (int s = 0; s < 8; ++s) { kf[0][s] = *(const bf16x8*)(kp + s * 16); kf[1][s] = *(const bf16x8*)(kp + (size_t)32 * 1024 + s * 16); }
      const bf16_t* qp = QN + (m0 + r32) * 1024 + h * 128 + hi * 8;
#pragma unroll
      for (int s = 0; s < 8; ++s) { qf[0][s] = *(const bf16x8*)(qp + s * 16); qf[1][s] = *(const bf16x8*)(qp + (size_t)32 * 1024 + s * 16); } }
    const float Gj0 = Gt[r32], Gj1 = Gt[32 + r32];
    { f32x16 c00 = {}, c10 = {}, c11 = {};
#pragma unroll
      for (int s = 0; s < 8; ++s) { c00 = __builtin_amdgcn_mfma_f32_32x32x16_bf16(kf[0][s], kf[0][s], c00, 0, 0, 0);
          c10 = __builtin_amdgcn_mfma_f32_32x32x16_bf16(kf[1][s], kf[0][s], c10, 0, 0, 0); c11 = __builtin_amdgcn_mfma_f32_32x32x16_bf16(kf[1][s], kf[1][s], c11, 0, 0, 0); }
#pragma unroll
      for (int q = 0; q < 4; ++q) {
          const f32x4 gA = *(const f32x4*)(Gt + 8 * q + 4 * hi), bA = *(const f32x4*)(Bt + 8 * q + 4 * hi), gB = *(const f32x4*)(Gt + 32 + 8 * q + 4 * hi), bB = *(const f32x4*)(Bt + 32 + 8 * q + 4 * hi);
#pragma unroll
          for (int e = 0; e < 4; ++e) { const int r = 4 * q + e, il0 = 8 * q + e, il = il0 + 4 * hi;
              const int o0 = hi ? ro4(il0 + 4) : ro4(il0), o1 = hi ? ro4(32 + il0 + 4) : ro4(32 + il0);
              if (r32 < il) Lp[o0 + r32] = bA[e] * c00[r] * __expf(gA[e] - Gj0);
              Lp[o1 + r32] = bB[e] * c10[r] * __expf(gB[e] - Gj0);
              if (r32 < il) Lp[o1 + 32 + r32] = bB[e] * c11[r] * __expf(gB[e] - Gj1); } } }
    { f32x16 d00 = {}, d10 = {}, d11 = {};
#pragma unroll
      for (int s = 0; s < 8; ++s) { const bf16x8 q0 = qf[0][s], q1 = qf[1][s];
          d00 = __builtin_amdgcn_mfma_f32_32x32x16_bf16(q0, kf[0][s], d00, 0, 0, 0);
          d10 = __builtin_amdgcn_mfma_f32_32x32x16_bf16(q1, kf[0][s], d10, 0, 0, 0); d11 = __builtin_amdgcn_mfma_f32_32x32x16_bf16(q1, kf[1][s], d11, 0, 0, 0); }
      bf16_t* qs_ = (bf16_t*)stg;
#pragma unroll
      for (int q = 0; q < 4; ++q) {
          const f32x4 gA = *(const f32x4*)(Gt + 8 * q + 4 * hi), gB = *(const f32x4*)(Gt + 32 + 8 * q + 4 * hi);
#pragma unroll
          for (int e = 0; e < 4; ++e) { const int r = 4 * q + e, il = 8 * q + e + 4 * hi;
          const float v00 = (r32 <= il) ? d00[r] * __expf(gA[e] - Gj0) : 0.f;
          const float v10 = d10[r] * __expf(gB[e] - Gj0);
          const float v11 = (r32 <= il) ? d11[r] * __expf(gB[e] - Gj1) : 0.f;
          qs_[il * 64 + r32] = (bf16_t)(cvtpk(v00, 0.f) & 0xffffu); qs_[il * 64 + 32 + r32] = (bf16_t)0;
          qs_[(32 + il) * 64 + r32] = (bf16_t)(cvtpk(v10, 0.f) & 0xffffu); qs_[(32 + il) * 64 + 32 + r32] = (bf16_t)(cvtpk(v11, 0.f) & 0xffffu); } }
      asm volatile("s_waitcnt lgkmcnt(0)" ::: "memory");
      const __amdgpu_buffer_rsrc_t rsQK = MKRS(qkbuf(F) + m0 * 512 + h * 64);
      const unsigned offQ = (unsigned)(((lane >> 3) * 512 + (lane & 7) * 8) * 2);
#pragma unroll
      for (int i = 0; i < 8; ++i) { const int e = i * 64 + lane, row = e >> 3, c = e & 7; bst128(*(const u32x4*)(stg + row * 128 + c * 16), rsQK, offQ, i * 8 * 512 * 2); } }
    asm volatile("s_waitcnt lgkmcnt(0)" ::: "memory");
    CLOADH(2); CLOADW(2, wA); CLOAD(2, rawA, 0); CLOAD(2, rawB, 1);
    CFENCE();
    float T[64];
    {
    constexpr int NCH = 528;
    f32x4 ring[8];
#pragma unroll
    for (int c = 0; c < 8; ++c) ring[c] = *(const f32x4*)(Lp + 4 * c);
    asm volatile("" ::: "memory");
    T[0] = (lane == 0) ? 1.f : 0.f;
#pragma unroll
    for (int i = 1; i < 64; ++i) { float acc = (lane == i) ? 1.f : 0.f;
#pragma unroll
        for (int q4 = 0; q4 < (i + 3) / 4; ++q4) { const int c = ro4(i) / 4 + q4; const f32x4 l4 = ring[c & 7];
#pragma unroll
            for (int e = 0; e < 4; ++e) if (4 * q4 + e < i) acc -= l4[e] * T[4 * q4 + e];
            if (c + 8 < NCH) { ring[c & 7] = *(const f32x4*)(Lp + 4 * (c + 8)); asm volatile("" ::: "memory"); } }
        T[i] = acc; }
    asm volatile("" : "+v"(T[63]) :: "memory"); }
    asm volatile("s_waitcnt lgkmcnt(0)" ::: "memory");
    const int vb0 = (int)(uintptr_t)stg + v_rd_base(lane);
    const float betac = Bt[lane], gcc = Gt[lane];
#pragma unroll
    for (int i = 0; i < 64; ++i) *(bf16_t*)(Tl + i * LT_PITCH + lane * 2) = (bf16_t)(cvtpk(T[i] * betac, 0.f) & 0xffffu);
    u32x4 vout[16];
#define CROWSV(R, blk, W) do { _Pragma("unroll") for (int j_ = 0; j_ < 8; ++j_) { f32x2_t x0[4]; UNPK(x0, R[j_]); f32x2_t y[4]; \
          _Pragma("unroll") for (int i = 0; i < 4; ++i) { f32x2_t a = W[0][i] * x3[i]; a = __builtin_elementwise_fma(W[1][i], x2[i], a); a = __builtin_elementwise_fma(W[2][i], x1[i], a); a = __builtin_elementwise_fma(W[3][i], x0[i], a); \
              f32x2_t e = a * (f32x2_t){-LOG2E, -LOG2E}; e = (f32x2_t){__builtin_amdgcn_exp2f(e.x), __builtin_amdgcn_exp2f(e.y)} + (f32x2_t){1.f, 1.f}; \
              a = a * (f32x2_t){__builtin_amdgcn_rcpf(e.x), __builtin_amdgcn_rcpf(e.y)}; y[i] = a; x3[i] = x2[i]; x2[i] = x1[i]; x1[i] = x0[i]; } \
          u32x4 o; o.x = cvtpk(y[0].x, y[0].y); o.y = cvtpk(y[1].x, y[1].y); o.z = cvtpk(y[2].x, y[2].y); o.w = cvtpk(y[3].x, y[3].y); vout[(blk) * 8 + j_] = o; } } while (0)
    CINIT();
    CROWSV(rawA, 0, wA);
    CROWSV(rawB, 1, wA);
#undef CROWSV
#undef CLOAD
#undef CLOADH
#undef CLOADW
#undef CINIT
#undef CROWS
#undef CFENCE
#undef UNPK
#pragma unroll
    for (int pass = 0; pass < 2; ++pass) {
        const float egc = __expf(gcc);
        const __amdgpu_buffer_rsrc_t rsX = MKRS((pass == 0 ? VN : KN) + m0 * 1024 + h * 128);
        const __amdgpu_buffer_rsrc_t rsW = MKRS(wbuf(F) + m0 * 1024 + h * 128);
        const unsigned offU = (unsigned)(((lane >> 3) * 1024 + ((lane >> 2) & 1) * 64 + (lane & 3) * 8) * 2);
        if (pass == 1) {
#pragma unroll
            for (int i = 0; i < 64; ++i) { bf16_t* tp = (bf16_t*)(Tl + i * LT_PITCH + lane * 2); *tp = (bf16_t)(cvtpk(__uint_as_float((unsigned)*tp << 16) * egc, 0.f) & 0xffffu); } }
        f32x16 acc0[4], acc1[4];
        bf16x8 xst[8];
#define STAGE_LOAD(hf) do { _Pragma("unroll") for (int i8 = 0; i8 < 8; ++i8) { xst[i8] = __builtin_bit_cast(bf16x8, bld128(rsX, offS, (32 * (hf) + 4 * i8) * 2048)); } } while (0)
#define STAGE_WRITE() do { _Pragma("unroll") for (int i8 = 0; i8 < 8; ++i8) { const int tok = 4 * i8 + (lane >> 4), c8 = (lane & 15) * 8; \
            *(bf16x8*)(stg + v_st(tok, c8)) = xst[i8]; } asm volatile("s_waitcnt lgkmcnt(0)" ::: "memory"); } while (0)
#define TRRD(dst, off) asm volatile("ds_read_b64_tr_b16 %0, %1 offset:%2" : "=&v"(dst) : "v"(vb0), "i"(off) : "memory")
#define MM_HALF(ACC, ib, kh) do { _Pragma("unroll") for (int d0 = 0; d0 < 4; ++d0) { s16x4 l0, h0, l1, h1; \
            if (d0 == 0) { TRRD(l0, 0); TRRD(h0, 2048); TRRD(l1, 4096); TRRD(h1, 6144); } else if (d0 == 1) { TRRD(l0, 512); TRRD(h0, 512 + 2048); TRRD(l1, 512 + 4096); TRRD(h1, 512 + 6144); } \
            else if (d0 == 2) { TRRD(l0, 1024); TRRD(h0, 1024 + 2048); TRRD(l1, 1024 + 4096); TRRD(h1, 1024 + 6144); } else { TRRD(l0, 1536); TRRD(h0, 1536 + 2048); TRRD(l1, 1536 + 4096); TRRD(h1, 1536 + 6144); } \
            const bf16x8 a0 = *(const bf16x8*)(Tl + (32 * (ib) + r32) * LT_PITCH + (16 * (2 * (kh)) + 8 * hi) * 2), a1 = *(const bf16x8*)(Tl + (32 * (ib) + r32) * LT_PITCH + (16 * (2 * (kh) + 1) + 8 * hi) * 2); \
            asm volatile("s_waitcnt lgkmcnt(0)" ::: "memory"); __builtin_amdgcn_sched_barrier(0); \
            ACC[d0] = __builtin_amdgcn_mfma_f32_32x32x16_bf16(a0, (bf16x8){l0[0], l0[1], l0[2], l0[3], h0[0], h0[1], h0[2], h0[3]}, ACC[d0], 0, 0, 0); \
            ACC[d0] = __builtin_amdgcn_mfma_f32_32x32x16_bf16(a1, (bf16x8){l1[0], l1[1], l1[2], l1[3], h1[0], h1[1], h1[2], h1[3]}, ACC[d0], 0, 0, 0); } } while (0)
#define STORE_OUT(ACC, ib) do { bf16_t* so_ = (bf16_t*)stg; _Pragma("unroll") for (int d0 = 0; d0 < 4; ++d0) _Pragma("unroll") for (int r = 0; r < 16; ++r) so_[crow(r, hi) * 128 + d0 * 32 + r32] = (bf16_t)(cvtpk(ACC[d0][r], 0.f) & 0xffffu); \
            asm volatile("s_waitcnt lgkmcnt(0)" ::: "memory"); \
            _Pragma("unroll") for (int i = 0; i < 8; ++i) { const int e = i * 64 + lane, row = e >> 4, c = e & 15; bst128(*(const u32x4*)(stg + row * 256 + c * 16), rsW, offS, (32 * (ib) + 4 * i) * 2048); } \
            asm volatile("s_waitcnt lgkmcnt(0)" ::: "memory"); } while (0)
#define STORE_UT(ACC, ib) do { _Pragma("unroll") for (int d0 = 0; d0 < 4; ++d0) _Pragma("unroll") for (int q_ = 0; q_ < 4; ++q_) { \
            u32x2 w_; w_.x = cvtpk(ACC[d0][4 * q_], ACC[d0][4 * q_ + 1]); w_.y = cvtpk(ACC[d0][4 * q_ + 2], ACC[d0][4 * q_ + 3]); \
            *(u32x2*)(stg + (d0 * 32 + r32) * 64 + (8 * q_ + 4 * hi) * 2) = w_; } \
            asm volatile("s_waitcnt lgkmcnt(0)" ::: "memory"); \
            _Pragma("unroll") for (int i = 0; i < 8; ++i) { const int e = i * 64 + lane, v_ = e >> 2, c = e & 3; \
                bst128(*(const u32x4*)(stg + v_ * 64 + c * 16), rsV, offU, (8 * i * 1024 + (ib) * 32) * 2); } \
            asm volatile("s_waitcnt lgkmcnt(0)" ::: "memory"); } while (0)
#define VWRITE(hf) do { if ((g4 >> 1) == (hf)) { _Pragma("unroll") for (int r_ = 0; r_ < 16; ++r_) *(u32x4*)(stg + v_st(16 * (g4 & 1) + r_, c8)) = vout[r_]; } asm volatile("s_waitcnt lgkmcnt(0)" ::: "memory"); } while (0)
        if (pass == 0) { VWRITE(0); } else { STAGE_LOAD(0); STAGE_WRITE(); }
        asm volatile("" ::: "memory");
#pragma unroll
        for (int d0 = 0; d0 < 4; ++d0) { acc0[d0] = f32x16{}; acc1[d0] = f32x16{}; }
        MM_HALF(acc0, 0, 0);
        MM_HALF(acc1, 1, 0);
        asm volatile("s_waitcnt lgkmcnt(0)" ::: "memory");
        if (pass == 1) { STORE_OUT(acc0, 0); STAGE_LOAD(1); STAGE_WRITE(); }
        else { VWRITE(1); }
        MM_HALF(acc1, 1, 1);
        asm volatile("s_waitcnt lgkmcnt(0)" ::: "memory");
        if (pass == 1) { STORE_OUT(acc1, 1); } else { STORE_UT(acc0, 0); STORE_UT(acc1, 1); }
#undef STORE_UT

#undef STAGE_LOAD
#undef STAGE_WRITE
#undef VWRITE
#undef TRRD
#undef MM_HALF
#undef STORE_OUT
    }
}

constexpr int S_WP = 272, S_QKP = 144, S_KP = 288, S_OP = 272;
constexpr int S_WL = 0, S_QL = 64 * S_WP, S_KL = 2 * 64 * S_WP, S_QKL = S_KL + 64 * S_KP, S_BUF = S_QKL + 64 * S_QKP;
constexpr int S_OT = 2 * S_BUF, S_OTSZ = 64 * S_OP, S_TAB = S_OT + 2 * S_OTSZ, S_TABSZ = 528, S_END = S_TAB + 2 * S_TABSZ;
static_assert(S_END <= LDS_BARST, "scan LDS map");
typedef unsigned long long u64_t;
__device__ __forceinline__ bf16x8 frag2(const char* p0, const char* p1) { const u64_t a = *(const u64_t*)p0, b = *(const u64_t*)p1; typedef u64_t u64x2 __attribute__((ext_vector_type(2))); const u64x2 w = {a, b}; return __builtin_bit_cast(bf16x8, w); }
__device__ __forceinline__ void scan_mfma(Ctx& F, char* lds, int layer, int bh) {
    const int tid_ = fresh_tid(F.wave);
    const int tid = tid_, lane = tid & 63, wave = F.wave, fr = lane & 15, g = lane >> 4;
    const bool is_compute = wave < 4;
    const int b = bh >> 3, h = bh & 7;
    const bf16_t* QN = (const bf16_t*)F.out; const bf16_t* KN = (const bf16_t*)((const char*)F.out + 32 * MiB); const bf16_t* UT = (const bf16_t*)(F.ws + WS_VN);
    const float* GB = (const float*)(F.ws + WS_GB); const bf16_t* PROJ = (const bf16_t*)(F.ws + WS_PROJ); bf16_t* MIXED = (bf16_t*)(F.ws + WS_MIXED);
    const size_t mb0 = (size_t)b * SEQ;
    const int vb = (wave & 3) * 32;
    f32x4 Sacc[2][8];
#pragma unroll
    for (int c = 0; c < 2; ++c)
#pragma unroll
        for (int d = 0; d < 8; ++d) Sacc[c][d] = (f32x4){0.f, 0.f, 0.f, 0.f};
    const __amdgpu_buffer_rsrc_t rsU = __builtin_amdgcn_make_buffer_rsrc((void*)UT, 0, 0x02000000, 0x00020000);
    unsigned offU[2];
#pragma unroll
    for (int c = 0; c < 2; ++c) { const int v = vb + 16 * c + fr; offU[c] = (unsigned)((((v >> 1) * 1024 + (v & 1) * 64) + 4 * g) * 2); }
    u32x2 uA[2][4], uB[2][4];
#define ULOAD(dst, nn) do { const unsigned so_ = (unsigned)(((mb0 + (size_t)(nn) * 64) * 1024 + h * 128) * 2); _Pragma("unroll") for (int c = 0; c < 2; ++c) _Pragma("unroll") for (int t = 0; t < 4; ++t) \
        dst[c][t] = __builtin_bit_cast(u32x2, __builtin_amdgcn_raw_buffer_load_b64(rsU, offU[c] + 32u * t, so_, 0)); } while (0)
    const int t2 = tid - 256;
    const int r0 = t2 >> 4, c0 = t2 & 15, rq = t2 >> 3, cq = t2 & 7;
    u32x4 pw[4], pq[4], pk[4], pqk[2]; float pg = 0.f, pgl = 0.f;
    const unsigned offN = (unsigned)((r0 * 1024 + c0 * 8) * 2), offQK = (unsigned)((rq * 512 + cq * 8) * 2);
#define SLOADC(nn) do { const char* wc_ = (const char*)(wbuf(F) + (mb0 + (size_t)(nn) * 64) * 1024 + h * 128); const char* qc_ = (const char*)(QN + (mb0 + (size_t)(nn) * 64) * 1024 + h * 128); \
        const char* kc_ = (const char*)(KN + (mb0 + (size_t)(nn) * 64) * 1024 + h * 128); const char* qkc_ = (const char*)(qkbuf(F) + (mb0 + (size_t)(nn) * 64) * 512 + h * 64); \
        _Pragma("unroll") for (int i = 0; i < 4; ++i) { pw[i] = *(const u32x4*)(wc_ + offN + (unsigned)(i * 16 * 1024 * 2)); pq[i] = *(const u32x4*)(qc_ + offN + (unsigned)(i * 16 * 1024 * 2)); pk[i] = *(const u32x4*)(kc_ + offN + (unsigned)(i * 16 * 1024 * 2)); } \
        pqk[0] = *(const u32x4*)(qkc_ + offQK); pqk[1] = *(const u32x4*)(qkc_ + offQK + 32u * 512u * 2u); \
        if (t2 < 64) { const char* gc_ = (const char*)(GB + (mb0 + (size_t)(nn) * 64) * 16 + h); pg = *(const float*)(gc_ + t2 * 64); pgl = *(const float*)(gc_ + 63 * 64); } } while (0)
#define SWRITEC(bufo, tabo) do { char* B_ = lds + (bufo); _Pragma("unroll") for (int i = 0; i < 4; ++i) { const int row = r0 + 16 * i; \
        *(u32x4*)(B_ + S_WL + row * S_WP + c0 * 16) = pw[i]; *(u32x4*)(B_ + S_QL + row * S_WP + c0 * 16) = pq[i]; *(u32x4*)(B_ + S_KL + row * S_KP + c0 * 16) = pk[i]; } \
        *(u32x4*)(B_ + S_QKL + rq * S_QKP + cq * 16) = pqk[0]; *(u32x4*)(B_ + S_QKL + (rq + 32) * S_QKP + cq * 16) = pqk[1]; \
        if (t2 < 64) { float* T_ = (float*)(lds + (tabo)); T_[t2] = __expf(pg); T_[64 + t2] = __expf(pgl - pg); if (t2 == 0) T_[128] = __expf(pgl); } } while (0)
    const int orow = t2 >> 2, oseg = t2 & 3;
    u32x4 zA[4], zB[4];
#define ZLOAD(dst, nn) do { const char* zc_ = (const char*)(PROJ + pj(mb0 + (size_t)(nn) * 64 + orow, C_GZ + h * 128 + oseg * 32)); _Pragma("unroll") for (int i = 0; i < 4; ++i) dst[i] = *(const u32x4*)(zc_ + i * 16); } while (0)
    float nwv[32];
    if (!is_compute) {
#pragma unroll
        for (int i = 0; i < 32; ++i) nwv[i] = F.gdn_norm_w[layer * 128 + oseg * 32 + i];
    }
#define OUTPUT(nn, OTO, Z) do { const char* op_ = lds + (OTO) + orow * S_OP + oseg * 64; float ov[32]; float ss = 0.f; \
        _Pragma("unroll") for (int i = 0; i < 4; ++i) { const u32x4 w = *(const u32x4*)(op_ + i * 16); ov[8 * i] = bf_lo(w.x); ov[8 * i + 1] = bf_hi(w.x); ov[8 * i + 2] = bf_lo(w.y); ov[8 * i + 3] = bf_hi(w.y); \
            ov[8 * i + 4] = bf_lo(w.z); ov[8 * i + 5] = bf_hi(w.z); ov[8 * i + 6] = bf_lo(w.w); ov[8 * i + 7] = bf_hi(w.w); } \
        _Pragma("unroll") for (int i = 0; i < 32; ++i) ss = __builtin_fmaf(ov[i], ov[i], ss); \
        ss += shx<1>(ss); ss += shx<2>(ss); \
        const float rs = frsq(ss * (1.0f / 128.0f) + RMS_EPS); \
        bf16_t* dp_ = MIXED + pj2(mb0 + (size_t)(nn) * 64 + orow, 1024 + h * 128 + oseg * 32); \
        _Pragma("unroll") for (int i = 0; i < 4; ++i) { const u32x4 z = Z[i]; u32x4 o; \
            o.x = cvtpk(ov[8 * i] * rs * nwv[8 * i] * bf_lo(z.x), ov[8 * i + 1] * rs * nwv[8 * i + 1] * bf_hi(z.x)); o.y = cvtpk(ov[8 * i + 2] * rs * nwv[8 * i + 2] * bf_lo(z.y), ov[8 * i + 3] * rs * nwv[8 * i + 3] * bf_hi(z.y)); \
            o.z = cvtpk(ov[8 * i + 4] * rs * nwv[8 * i + 4] * bf_lo(z.z), ov[8 * i + 5] * rs * nwv[8 * i + 5] * bf_hi(z.z)); o.w = cvtpk(ov[8 * i + 6] * rs * nwv[8 * i + 6] * bf_lo(z.w), ov[8 * i + 7] * rs * nwv[8 * i + 7] * bf_hi(z.w)); \
            *(u32x4*)(dp_ + i * 8) = o; } } while (0)
#define COMPUTE_STEP(n, CUR, UC, UN) do { \
        if ((n) + 1 < 64) { ULOAD(UN, (n) + 1); } \
        const char* Wl = lds + (CUR) * S_BUF + S_WL; const char* Ql = lds + (CUR) * S_BUF + S_QL; const char* Kl = lds + (CUR) * S_BUF + S_KL; const char* QKl = lds + (CUR) * S_BUF + S_QKL; \
        const float* EG = (const float*)(lds + S_TAB + (CUR) * S_TABSZ); const float* E2 = EG + 64; char* Ot = lds + S_OT + (CUR) * S_OTSZ; \
          \
        bf16x8 sb[2][4]; \
        _Pragma("unroll") for (int c = 0; c < 2; ++c) _Pragma("unroll") for (int s = 0; s < 4; ++s) { \
            const u32x4 w = {cvtpk(Sacc[c][2 * s][0], Sacc[c][2 * s][1]), cvtpk(Sacc[c][2 * s][2], Sacc[c][2 * s][3]), cvtpk(Sacc[c][2 * s + 1][0], Sacc[c][2 * s + 1][1]), cvtpk(Sacc[c][2 * s + 1][2], Sacc[c][2 * s + 1][3])}; \
            sb[c][s] = __builtin_bit_cast(bf16x8, w); } \
          \
        f32x4 vn[2][4], oo[2][4]; \
        bf16x8 wa[4], qa[4]; \
        _Pragma("unroll") for (int s = 0; s < 4; ++s) { const char* wr_ = Wl + fr * S_WP + 8 * g; const char* qr_ = Ql + fr * S_WP + 8 * g; wa[s] = frag2(wr_ + 64 * s, wr_ + 64 * s + 32); qa[s] = frag2(qr_ + 64 * s, qr_ + 64 * s + 32); } \
        _Pragma("unroll") for (int t = 0; t < 4; ++t) { \
            float eg4[4]; \
            _Pragma("unroll") for (int ii = 0; ii < 4; ++ii) eg4[ii] = EG[16 * t + 4 * g + ii]; \
            __builtin_amdgcn_sched_barrier(0); \
            f32x4 a1[2], a2[2]; \
            _Pragma("unroll") for (int c = 0; c < 2; ++c) { a1[c] = (f32x4){0.f, 0.f, 0.f, 0.f}; a2[c] = (f32x4){0.f, 0.f, 0.f, 0.f}; } \
            _Pragma("unroll") for (int s = 0; s < 4; ++s) _Pragma("unroll") for (int c = 0; c < 2; ++c) a1[c] = __builtin_amdgcn_mfma_f32_16x16x32_bf16(wa[s], sb[c][s], a1[c], 0, 0, 0); \
            __builtin_amdgcn_sched_barrier(0); \
            if (t < 3) { _Pragma("unroll") for (int s = 0; s < 4; ++s) { const char* wr_ = Wl + (16 * (t + 1) + fr) * S_WP + 8 * g; wa[s] = frag2(wr_ + 64 * s, wr_ + 64 * s + 32); } } \
            __builtin_amdgcn_sched_barrier(0); \
            _Pragma("unroll") for (int s = 0; s < 4; ++s) _Pragma("unroll") for (int c = 0; c < 2; ++c) a2[c] = __builtin_amdgcn_mfma_f32_16x16x32_bf16(qa[s], sb[c][s], a2[c], 0, 0, 0); \
            __builtin_amdgcn_sched_barrier(0); \
            if (t < 3) { _Pragma("unroll") for (int s = 0; s < 4; ++s) { const char* qr_ = Ql + (16 * (t + 1) + fr) * S_WP + 8 * g; qa[s] = frag2(qr_ + 64 * s, qr_ + 64 * s + 32); } } \
            _Pragma("unroll") for (int c = 0; c < 2; ++c) { const u32x2 uw = UC[c][t]; const float u0 = bf_lo(uw.x), u1 = bf_hi(uw.x), u2 = bf_lo(uw.y), u3 = bf_hi(uw.y); \
                vn[c][t] = (f32x4){u0 - a1[c][0], u1 - a1[c][1], u2 - a1[c][2], u3 - a1[c][3]}; \
                oo[c][t] = (f32x4){a2[c][0] * eg4[0], a2[c][1] * eg4[1], a2[c][2] * eg4[2], a2[c][3] * eg4[3]}; } } \
          \
        bf16x8 vb2[2][2], vb3[2][2]; \
        { _Pragma("unroll") for (int s2 = 0; s2 < 2; ++s2) { float e2v[8]; \
            _Pragma("unroll") for (int ii = 0; ii < 4; ++ii) { e2v[ii] = E2[32 * s2 + 4 * g + ii]; e2v[4 + ii] = E2[32 * s2 + 16 + 4 * g + ii]; } \
            _Pragma("unroll") for (int c = 0; c < 2; ++c) { \
            const u32x4 w = {cvtpk(vn[c][2 * s2][0], vn[c][2 * s2][1]), cvtpk(vn[c][2 * s2][2], vn[c][2 * s2][3]), cvtpk(vn[c][2 * s2 + 1][0], vn[c][2 * s2 + 1][1]), cvtpk(vn[c][2 * s2 + 1][2], vn[c][2 * s2 + 1][3])}; \
            vb2[c][s2] = __builtin_bit_cast(bf16x8, w); \
            const u32x4 w3 = {cvtpk(vn[c][2 * s2][0] * e2v[0], vn[c][2 * s2][1] * e2v[1]), cvtpk(vn[c][2 * s2][2] * e2v[2], vn[c][2 * s2][3] * e2v[3]), \
                              cvtpk(vn[c][2 * s2 + 1][0] * e2v[4], vn[c][2 * s2 + 1][1] * e2v[5]), cvtpk(vn[c][2 * s2 + 1][2] * e2v[6], vn[c][2 * s2 + 1][3] * e2v[7])}; \
            vb3[c][s2] = __builtin_bit_cast(bf16x8, w3); } } \
          __builtin_amdgcn_sched_barrier(0); \
          { const char* ar0 = QKl + fr * S_QKP + 8 * g; const bf16x8 f0 = frag2(ar0, ar0 + 32), f1 = frag2(ar0 + 16 * S_QKP, ar0 + 16 * S_QKP + 32); \
            _Pragma("unroll") for (int c = 0; c < 2; ++c) { oo[c][0] = __builtin_amdgcn_mfma_f32_16x16x32_bf16(f0, vb2[c][0], oo[c][0], 0, 0, 0); oo[c][1] = __builtin_amdgcn_mfma_f32_16x16x32_bf16(f1, vb2[c][0], oo[c][1], 0, 0, 0); } } \
          __builtin_amdgcn_sched_barrier(0); \
          { const char* ar2 = QKl + (32 + fr) * S_QKP + 8 * g; const bf16x8 f0 = frag2(ar2, ar2 + 32), f1 = frag2(ar2 + 64, ar2 + 96), f2 = frag2(ar2 + 16 * S_QKP, ar2 + 16 * S_QKP + 32), f3 = frag2(ar2 + 16 * S_QKP + 64, ar2 + 16 * S_QKP + 96); \
            _Pragma("unroll") for (int c = 0; c < 2; ++c) { oo[c][2] = __builtin_amdgcn_mfma_f32_16x16x32_bf16(f0, vb2[c][0], oo[c][2], 0, 0, 0); oo[c][3] = __builtin_amdgcn_mfma_f32_16x16x32_bf16(f2, vb2[c][0], oo[c][3], 0, 0, 0); \
                oo[c][2] = __builtin_amdgcn_mfma_f32_16x16x32_bf16(f1, vb2[c][1], oo[c][2], 0, 0, 0); oo[c][3] = __builtin_amdgcn_mfma_f32_16x16x32_bf16(f3, vb2[c][1], oo[c][3], 0, 0, 0); } } \
          __builtin_amdgcn_sched_barrier(0); } \
          \
        { const float aa = EG[128]; \
          const unsigned kaddr = (unsigned)(uintptr_t)Kl + (unsigned)((4 * g + ((lane & 15) >> 2)) * S_KP + (lane & 3) * 8); \
          _Pragma("unroll") for (int c = 0; c < 2; ++c) _Pragma("unroll") for (int db = 0; db < 8; ++db) Sacc[c][db] = Sacc[c][db] * aa; \
          _Pragma("unroll") for (int dp = 0; dp < 4; ++dp) { s16x4 klo[2][2], khi[2][2]; \
            _Pragma("unroll") for (int dd = 0; dd < 2; ++dd) _Pragma("unroll") for (int s2 = 0; s2 < 2; ++s2) { \
                asm volatile("ds_read_b64_tr_b16 %0, %1 offset:%2" : "=&v"(klo[dd][s2]) : "v"(kaddr), "i"(s2 * 32 * S_KP + (2 * dp + dd) * 32) : "memory"); \
                asm volatile("ds_read_b64_tr_b16 %0, %1 offset:%2" : "=&v"(khi[dd][s2]) : "v"(kaddr), "i"(s2 * 32 * S_KP + 16 * S_KP + (2 * dp + dd) * 32) : "memory"); } \
            asm volatile("s_waitcnt lgkmcnt(0)" ::: "memory"); __builtin_amdgcn_sched_barrier(0); \
            _Pragma("unroll") for (int s2 = 0; s2 < 2; ++s2) _Pragma("unroll") for (int dd = 0; dd < 2; ++dd) { const s16x4 lo_ = klo[dd][s2], hi_ = khi[dd][s2]; \
                const bf16x8 kfr = (bf16x8){lo_[0], lo_[1], lo_[2], lo_[3], hi_[0], hi_[1], hi_[2], hi_[3]}; \
                _Pragma("unroll") for (int c = 0; c < 2; ++c) Sacc[c][2 * dp + dd] = __builtin_amdgcn_mfma_f32_16x16x32_bf16(kfr, vb3[c][s2], Sacc[c][2 * dp + dd], 0, 0, 0); } \
            __builtin_amdgcn_sched_barrier(0); } } \
          \
        _Pragma("unroll") for (int c = 0; c < 2; ++c) _Pragma("unroll") for (int t = 0; t < 4; ++t) _Pragma("unroll") for (int ii = 0; ii < 4; ++ii) \
            *(bf16_t*)(Ot + (16 * t + 4 * g + ii) * S_OP + (vb + 16 * c + fr) * 2) = (bf16_t)(cvtpk(oo[c][t][ii], 0.f) & 0xffffu); \
    } while (0)
#define IO_STEP(n, NXT, ZC, ZN) do { \
        if ((n) + 1 < 64) { SWRITEC((NXT) * S_BUF, S_TAB + (NXT) * S_TABSZ); } \
        if ((n) < 64) { ZLOAD(ZN, (n)); } \
        if ((n) + 2 < 64) { SLOADC((n) + 2); } \
        if ((n) >= 1) { OUTPUT((n) - 1, S_OT + (NXT) * S_OTSZ, ZC); } \
    } while (0)
    if (is_compute) { ULOAD(uA, 0); }
    else { SLOADC(0); SWRITEC(0, S_TAB); SLOADC(1); }
    __syncthreads();
#define SCAN_BAR() do { asm volatile("s_waitcnt lgkmcnt(0)" ::: "memory"); __builtin_amdgcn_s_barrier(); asm volatile("" ::: "memory"); } while (0)
    if (is_compute) {
#pragma unroll 1
        for (int n = 0; n < 64; n += 2) {
            COMPUTE_STEP(n, 0, uA, uB); SCAN_BAR();
            COMPUTE_STEP(n + 1, 1, uB, uA); SCAN_BAR();
        }
    } else {
#pragma unroll 1
        for (int n = 0; n < 64; n += 2) {
            IO_STEP(n, 1, zB, zA); SCAN_BAR();
            IO_STEP(n + 1, 0, zA, zB); SCAN_BAR();
        }
        OUTPUT(63, S_OT + 1 * S_OTSZ, zB);
    }
#undef COMPUTE_STEP
#undef IO_STEP
#undef OUTPUT
#undef ZLOAD
#undef SLOADC
#undef SWRITEC
#undef ULOAD
}
}

#define XB_TMO      128
#define XB_XCNT(j)  (256  + 64 * (j))
#define XB_XSUB(j)  (1280 + 64 * (j))
#define XB_XGEN(j)  (2304 + 64 * (j))
#define XB_TOP      3328
#define XB_TOPGEN   3392
#define XCD_BAR_WORDS 3456
#define XB_SPIN_CAP (1u << 18)

__device__ __forceinline__ unsigned xb_ld(unsigned* p)              { return __hip_atomic_load(p, __ATOMIC_RELAXED, __HIP_MEMORY_SCOPE_AGENT); }
__device__ __forceinline__ unsigned xb_add(unsigned* p, unsigned v) { return __hip_atomic_fetch_add(p, v, __ATOMIC_RELAXED, __HIP_MEMORY_SCOPE_AGENT); }
__device__ __forceinline__ unsigned xb_xcc_id() { return (unsigned)__builtin_amdgcn_s_getreg((3 << 11) | 20) & 0xFu; }
#define XB_SPIN(cond, bar) do { unsigned _sp = 0; while (cond) { __builtin_amdgcn_s_sleep(1); \
    if ((++_sp & 255u) == 0u) { if (xb_ld(&(bar)[XB_TMO])) break; if (_sp > XB_SPIN_CAP) { atomicAdd(&(bar)[XB_TMO], 1u); break; } } } } while (0)

struct XcdBarrier {
    unsigned* bar; unsigned x;
    volatile LAS unsigned* st;
};

__device__ __forceinline__ XcdBarrier xcd_barrier_post(unsigned* bar, volatile LAS unsigned* st) {
    XcdBarrier b; b.bar = bar; b.x = xb_xcc_id(); b.st = st;
    if (threadIdx.x == 0) (void)xb_add(&bar[XB_XCNT(b.x)], 1u);
    return b;
}
__device__ __forceinline__ void xcd_barrier_complete(unsigned* bar, unsigned x, unsigned& nloc, unsigned& nx) {
    const unsigned G = gridDim.x * gridDim.y * gridDim.z;
    unsigned sum, cnt, mine, sp = 0u;
    for (;;) {
        sum = 0u; cnt = 0u; mine = 0u;
#pragma unroll
        for (unsigned j = 0; j < 16; ++j) { const unsigned c = xb_ld(&bar[XB_XCNT(j)]); sum += c; cnt += (c > 0u) ? 1u : 0u; mine = (j == x) ? c : mine; }
        if (sum == G) break;
        __builtin_amdgcn_s_sleep(1);
        if ((++sp & 255u) == 0u) { if (xb_ld(&bar[XB_TMO])) break; if (sp > XB_SPIN_CAP) { atomicAdd(&bar[XB_TMO], 1u); break; } }
    }
    nloc = mine > 0u ? mine : 1u; nx = cnt > 0u ? cnt : 1u;
}

__device__ __forceinline__ void xcd_barrier(const XcdBarrier& b, const int wave_id) {
    asm volatile("s_waitcnt vmcnt(0)" ::: "memory");
    __syncthreads();
    if (wave_id == 0 && b.st[0] == 0u) {
        const int l_ = fresh_tid(0);
        const unsigned G_ = gridDim.x * gridDim.y * gridDim.z;
        unsigned sum_, cnt_, mine_, sp_ = 0u;
        for (;;) {
            const unsigned c_ = (l_ < 16) ? xb_ld(&b.bar[XB_XCNT(l_)]) : 0u;
            sum_ = 0u; cnt_ = 0u;
#pragma unroll
            for (int j = 0; j < 16; ++j) { const unsigned cj = (unsigned)__builtin_amdgcn_readlane((int)c_, j); sum_ += cj; cnt_ += (cj > 0u) ? 1u : 0u; }
            mine_ = (unsigned)__builtin_amdgcn_readlane((int)c_, (int)b.x);
            if (sum_ == G_) break;
            __builtin_amdgcn_s_sleep(1);
            if ((++sp_ & 255u) == 0u) { if (__builtin_amdgcn_readfirstlane((int)xb_ld(&b.bar[XB_TMO]))) break; if (sp_ > XB_SPIN_CAP) { if (l_ == 0) atomicAdd(&b.bar[XB_TMO], 1u); break; } }
        }
        if (l_ == 0) { b.st[0] = mine_ > 0u ? mine_ : 1u; b.st[1] = cnt_ > 0u ? cnt_ : 1u; }
        asm volatile("s_waitcnt lgkmcnt(0)" ::: "memory");
    }
    if (fresh_tid(wave_id) == 0) {
        unsigned* bar = b.bar; asm volatile("" : "+s"(bar));
        __builtin_amdgcn_s_waitcnt(0);
        unsigned nloc = b.st[0], nx = b.st[1];
        if (nloc == 0u) { xcd_barrier_complete(bar, b.x, nloc, nx); b.st[0] = nloc; b.st[1] = nx; }
        const unsigned old = xb_add(&bar[XB_XSUB(b.x)], 1u);
        const unsigned gen = old / nloc;
        if (old + 1u == (gen + 1u) * nloc) {
            __builtin_amdgcn_fence(__ATOMIC_RELEASE, "agent");
            asm volatile("s_waitcnt vmcnt(0)" ::: "memory");
            const unsigned og = xb_add(&bar[XB_TOP], 1u);
            const unsigned tg = og / nx;
            if (og + 1u == (tg + 1u) * nx) xb_add(&bar[XB_TOPGEN], 1u);
            else XB_SPIN(xb_ld(&bar[XB_TOPGEN]) == tg, bar);
            __builtin_amdgcn_fence(__ATOMIC_ACQUIRE, "agent");
            xb_add(&bar[XB_XGEN(b.x)], 1u);
            asm volatile("s_waitcnt vmcnt(0)" ::: "memory");
        } else {
            XB_SPIN(xb_ld(&bar[XB_XGEN(b.x)]) == gen, bar);
            __builtin_amdgcn_fence(__ATOMIC_ACQUIRE, "agent");
            asm volatile("s_waitcnt vmcnt(0)" ::: "memory");
        }
    }
    __syncthreads();
}

__global__ void __launch_bounds__(512, 2) hybrid_fwd(Args args) {
    extern __shared__ __attribute__((aligned(16))) unsigned char lds[];
    cg::grid_group grid = cg::this_grid();
    Ctx F;
    F.tid = threadIdx.x; F.lane = F.tid & 63; F.wave = __builtin_amdgcn_readfirstlane(F.tid >> 6); F.bid = blockIdx.x; F.G = gridDim.x;
    F.x = args.in[0]; F.norm_w = args.in[1]; F.w_in = args.in[2]; F.w_out = args.in[3]; F.lq1 = args.in[4]; F.lk1 = args.in[5]; F.lq2 = args.in[6]; F.lk2 = args.in[7];
    F.subln_w = args.in[8]; F.rel_bias = args.in[9]; F.conv_w = args.in[10]; F.a_log = args.in[11]; F.dt_bias = args.in[12]; F.gdn_norm_w = args.in[13]; F.final_w = args.in[14];
    F.out = args.out; F.ws = args.ws;
    LAS unsigned char* ldsl = (LAS unsigned char*)lds;
    LAS float* rstd_l = (LAS float*)(ldsl + LDSX_OFF);
    volatile LAS unsigned* barst = (volatile LAS unsigned*)(ldsl + LDS_BARST);
    if (F.tid < 2) barst[F.tid] = 0u;
    __syncthreads();
    if (F.bid == 0) { u32x4* cw = (u32x4*)(F.ws + WS_CTL);
#pragma unroll
        for (int i = 0; i < 8; ++i) cw[i * 512 + F.tid] = (u32x4){0u, 0u, 0u, 0u}; }

    grid.sync();
    XcdBarrier bar = xcd_barrier_post((unsigned*)(F.ws + WS_CTL) + 4096, barst);
    for (int rep_ = 0; rep_ < REP_P0; ++rep_) p0_prologue(F, ldsl);
    xcd_barrier(bar, F.wave);

#pragma unroll 1
    for (int layer = 0; layer < 2; ++layer) {
        const float lambda_init = (layer == 0) ? 0.2f : 0.35550906759f;
        {
            relaunder(F);
#ifndef REP_BA
#define REP_BA 1
#endif
            for (int rb_ = 0; rb_ < REP_BA; ++rb_) ba_job(F, ldsl, layer);
            pg8::Gemm g{(const bf16_t*)(F.ws + WS_XB), (const bf16_t*)(F.ws + WS_WIN) + (size_t)layer * NPROJ * DM, M, NPROJ, DM};
            pg8::StaticOrder S; S.init(M, NPROJ, F.G, F.bid);
            pg8::Unit u0; S.next(0, u0);
            rstd_table(F, rstd_l, u0.pm * 256, 256);
            __syncthreads();
            pg8::EpiProj E{(bf16_t*)(F.ws + WS_PROJ), rstd_l, QSCALE};
            for (int rep_ = 0; rep_ < REP_P1; ++rep_) pg8::gemm_phase<pg8::EpiProj, pg8::StaticOrder, PG8_ALIGN_P1, PG8_SP2_ALL>(ldsl, g, S, E, F.wave);
        }
        xcd_barrier(bar, F.wave);
        relaunder(F);
        { const int gw = F.bid * 8 + F.wave; if (gw < 2048) gdn::chunk_prep(F, (char*)lds + F.wave * gdn::WAVE_LDS, layer, gw); }
        xcd_barrier(bar, F.wave);
        relaunder(F);
        { int bidv = F.bid; asm volatile("" : "+s"(bidv));
          if (bidv < 32) {
            for (int rep_ = 0; rep_ < REP_SCAN; ++rep_) gdn::scan_mfma(F, (char*)lds, layer, bidv);
          } }
        relaunder(F);
#ifdef PROBE_SERIAL
        xcd_barrier(bar, F.wave);
#endif
        {
            float d1 = F.lq1[layer * 64 + F.lane] * F.lk1[layer * 64 + F.lane], d2 = F.lq2[layer * 64 + F.lane] * F.lk2[layer * 64 + F.lane];
            d1 = wave_sum(d1); d2 = wave_sum(d2);
            const float lam = __expf(d1) - __expf(d2) + lambda_init;
            unsigned* wq = (unsigned*)(F.ws + WS_CTL) + 8192 + layer * 64;
            volatile LAS unsigned* wql = (volatile LAS unsigned*)(ldsl + LDS_BARST + 16);
            bool have = false; int uraw = 0;
            for (;;) {
                if (!have) {
                    if (F.tid == 0) wql[0] = __hip_atomic_fetch_add(wq, 1u, __ATOMIC_RELAXED, __HIP_MEMORY_SCOPE_AGENT);
                    __syncthreads();
                    uraw = (int)wql[0];
                    __syncthreads(); }
                have = false;
                int u = uraw;
                if (layer == 0) {
                    constexpr int WB = 32, NWB = (P0_LAYER_ITEMS + WB - 1) / WB;
                    if (u < 4 * NWB && (u & 3) == 3) {
                        relaunder(F);
#pragma unroll 1
                        for (int k = 0; k < WB / 8; ++k) { const int it = (u >> 2) * WB + k * 8 + F.wave; if (it < P0_LAYER_ITEMS) p0_weight_item(F, (LAS float*)(ldsl + F.wave * 17408), 1, it); }
                        __syncthreads();
                        continue; }
                    u -= (u < 4 * NWB) ? (u >> 2) : NWB; }
                if (u >= 512) break;
                const int qb = 15 - (u >> 5), bh = u & 31;
                if (F.wave >= 4) att::attn_unit<true>(F, (char*)lds, layer, bh >> 3, bh & 7, qb, lam, 1.0f - lambda_init, wq, wql);
                else att::attn_unit<false>(F, (char*)lds, layer, bh >> 3, bh & 7, qb, lam, 1.0f - lambda_init, wq, wql);
                uraw = (int)wql[0]; have = true;
            }
        }
        xcd_barrier(bar, F.wave);
        {
            relaunder(F);
            pg8::Gemm g{(const bf16_t*)(F.ws + WS_MIXED), (const bf16_t*)(F.ws + WS_WOUT) + (size_t)layer * DM * DM, M, DM, DM};
            pg8::StaticOrder S; S.init(M, DM, F.G, F.bid);
            { pg8::EpiOut<true> E{nullptr, (bf16_t*)(F.ws + WS_XB), (float*)(F.ws + WS_ROWSQ)};
                pg8::gemm_phase<pg8::EpiOut<true>, pg8::StaticOrder, true, PG8_SP2_ALL>(ldsl, g, S, E, F.wave); }
        }
        xcd_barrier(bar, F.wave);
    }
    {
        relaunder(F);
        const int gw = F.bid * 8 + F.wave, NGW = F.G * 8; const float* RQ = (const float*)(F.ws + WS_ROWSQ);
        for (int m = gw; m < M; m += NGW) {
            float s = (F.lane < 32) ? RQ[(size_t)m * 32 + F.lane] : 0.f; s = wave_sum(s);
            const float rs = frsq(s * (1.0f / DM) + RMS_EPS);
            u32x2 xv8[8]; f32x4 w8[8];
            const bf16_t* xr = (const bf16_t*)(F.ws + WS_XB) + pj2((size_t)m, 4 * F.lane); f32x4* orow = (f32x4*)(F.out + (size_t)m * DM) + F.lane; const f32x4* wr_ = (const f32x4*)F.final_w + F.lane;
#pragma unroll
            for (int j = 0; j < 8; ++j) { xv8[j] = *(const u32x2*)(xr + (size_t)j * 8 * 2048); w8[j] = wr_[64 * j]; }
#pragma unroll
            for (int j = 0; j < 8; ++j) { const u32x2 xv = xv8[j]; const f32x4 w = w8[j];
                orow[64 * j] = (f32x4){bf_lo(xv.x) * rs * w[0], bf_hi(xv.x) * rs * w[1], bf_lo(xv.y) * rs * w[2], bf_hi(xv.y) * rs * w[3]}; }
        }
    }
}

extern "C" void kernel_launch(void* const* d_in, const int* in_sizes, int n_in, void* d_out, int out_size, void* d_ws, size_t ws_size, hipStream_t stream) {
    static int grid = 0;
    if (grid == 0) {
        if (n_in != 15 || in_sizes[0] != M * DM || out_size != M * DM || ws_size < WS_END) {
            fprintf(stderr, "kernel_launch: unexpected shapes (n_in %d, in0 %d, out %d, ws %zu < %zu)\n", n_in, n_in > 0 ? in_sizes[0] : -1, out_size, ws_size, (size_t)WS_END); grid = -1; return; }
        int dev = 0, cus = 0, per_cu = 0;
        (void)hipGetDevice(&dev); (void)hipDeviceGetAttribute(&cus, hipDeviceAttributeMultiprocessorCount, dev);
        if (hipFuncSetAttribute((const void*)hybrid_fwd, hipFuncAttributeMaxDynamicSharedMemorySize, LDS_BYTES) != hipSuccess) { fprintf(stderr, "kernel_launch: hipFuncSetAttribute failed\n"); grid = -1; return; }
        (void)hipOccupancyMaxActiveBlocksPerMultiprocessor(&per_cu, (const void*)hybrid_fwd, 512, LDS_BYTES);
        if (per_cu < 1) { fprintf(stderr, "kernel_launch: occupancy query says %d blocks per CU\n", per_cu); grid = -1; return; }
        grid = cus;
        if (grid != 256) fprintf(stderr, "kernel_launch: note: %d CUs (built for 256)\n", grid);
    }
    if (grid < 0) return;
    Args a{};
    for (int i = 0; i < 15; ++i) a.in[i] = (const float*)d_in[i];
    a.out = (float*)d_out; a.ws = (unsigned char*)d_ws;
    void* kargs[] = {&a};
    hipError_t e = hipLaunchCooperativeKernel((const void*)hybrid_fwd, dim3(grid), dim3(512), kargs, LDS_BYTES, stream);
    if (e != hipSuccess) fprintf(stderr, "kernel_launch: cooperative launch failed: %s\n", hipGetErrorString(e));
}
```

```cpp
#include <hip/hip_runtime.h>
#include <hip/hip_cooperative_groups.h>
#include <cstdio>
#include <cstdint>
namespace cg = cooperative_groups;
namespace pg8 {
#define PG8_LAS __attribute__((address_space(3)))
typedef unsigned short bf16_t;
typedef short bf16x8 __attribute__((ext_vector_type(8)));
typedef float f32x4 __attribute__((ext_vector_type(4)));
typedef unsigned u32x4 __attribute__((ext_vector_type(4)));
constexpr int BM = 256, BK = 64, HALF = 128, HTB = HALF * BK * 2  , STAGE_BYTES = 8 * HTB, NXCD = 8, WGM = 8;

__host__ __device__ __forceinline__ int lds_byte(int r, int c) { const int st = (r >> 4) * 2 + (c >> 5), rr = r & 15, cc = c & 31, ob = rr * 64 + cc * 2; return st * 1024 + (ob ^ (((ob >> 9) & 1) << 5)); }
__host__ __device__ __forceinline__ void stage_rc(int b, int& R, int& C) { const int st = b / 1024, sb = b % 1024, swz = sb ^ (((sb >> 9) & 1) << 5); R = (st >> 1) * 16 + swz / 64; C = (st & 1) * 32 + (swz % 64) / 2; }
__host__ __device__ __forceinline__ int perm32(int rho) { const int n = rho >> 4, i = rho & 15; return 8 * (i >> 2) + 4 * n + (i & 3); }

struct Unit { int pm, pn; };
struct Gemm { const bf16_t* A; const bf16_t* Bt; int M, N, K; };

struct StaticOrder {
    int nM, nN, nwg, G, c;
    __host__ __device__ void init(int M, int N, int G_, int c_) { nM = M / BM; nN = N / BM; nwg = nM * nN; G = G_; c = c_; }
    __host__ __device__ bool next(int i, Unit& u) const {
        const long L = (long)i * G + c; if (L >= nwg) return false;
        int wgid = (int)L; { const int q = nwg / NXCD, r = nwg % NXCD, xcd = wgid % NXCD, off = wgid / NXCD; wgid = (xcd < r ? xcd * (q + 1) : r * (q + 1) + (xcd - r) * q) + off; }
        const int nig = WGM * nN, gid = wgid / nig, fm = gid * WGM, gsz = (nM - fm) < WGM ? (nM - fm) : WGM;
        u.pm = fm + ((wgid % nig) % gsz); u.pn = (wgid % nig) / gsz; return true;
    }
    __device__ __forceinline__ void a_ready(const Unit&) const {}
    __device__ __forceinline__ void done(const Unit&) const {}
};


__device__ __forceinline__ unsigned cvt_pk_bf16(float lo, float hi) { unsigned r; asm volatile("v_cvt_pk_bf16_f32 %0, %1, %2" : "=v"(r) : "v"(lo), "v"(hi)); return r; }
typedef unsigned u32x2 __attribute__((ext_vector_type(2)));

struct EpiProj {
    static constexpr bool PERM = true, AFTER_DRAIN = false, IDEMPOTENT = true;
    bf16_t* O; const PG8_LAS float* rstd; float qscale;
    __device__ __forceinline__ void operator()(const f32x4 (&acc)[2][2][4][2], const Unit& u, int wr, int wc, int fr, int fq) const {
        const int col0 = u.pn * BM + wc * 32 + 8 * fq;
        const float sc = (u.pn < 4) ? qscale : 1.f;
        const bool act = (u.pn >= 12 && u.pn < 16) || (u.pn >= 28);
#pragma unroll
        for (int ai = 0; ai < 2; ++ai)
#pragma unroll
            for (int m = 0; m < 4; ++m) { const int r = ai * HALF + wr * 64 + m * 16 + fr; const float s = rstd[r] * sc;
                bf16_t* rowp = O + ((size_t)((u.pm * 4 + ai * 2 + wr) * 256 + u.pn * 8 + wc) * 2048 + (m * 16 + fr) * 32 + 8 * fq);
#pragma unroll
                for (int bj = 0; bj < 2; ++bj) { f32x4 v0 = acc[ai][bj][m][0] * s, v1 = acc[ai][bj][m][1] * s;
                    if (act) { typedef float f32x2p __attribute__((ext_vector_type(2)));
                        _Pragma("unroll") for (int e_ = 0; e_ < 4; e_ += 2) { f32x2p a = {v0[e_], v0[e_ + 1]}, c = {v1[e_], v1[e_ + 1]};
                            f32x2p ea = a * (f32x2p){-1.4426950408889634f, -1.4426950408889634f}, ec = c * (f32x2p){-1.4426950408889634f, -1.4426950408889634f};
                            ea = (f32x2p){__builtin_amdgcn_exp2f(ea.x), __builtin_amdgcn_exp2f(ea.y)} + (f32x2p){1.f, 1.f}; ec = (f32x2p){__builtin_amdgcn_exp2f(ec.x), __builtin_amdgcn_exp2f(ec.y)} + (f32x2p){1.f, 1.f};
                            a = a * (f32x2p){__builtin_amdgcn_rcpf(ea.x), __builtin_amdgcn_rcpf(ea.y)}; c = c * (f32x2p){__builtin_amdgcn_rcpf(ec.x), __builtin_amdgcn_rcpf(ec.y)};
                            v0[e_] = a.x; v0[e_ + 1] = a.y; v1[e_] = c.x; v1[e_ + 1] = c.y; } }
                    u32x4 w; w.x = cvt_pk_bf16(v0[0], v0[1]); w.y = cvt_pk_bf16(v0[2], v0[3]); w.z = cvt_pk_bf16(v1[0], v1[1]); w.w = cvt_pk_bf16(v1[2], v1[3]);
                    *(u32x4*)(rowp + bj * 4 * 2048) = w;
                } }
    }
};
template <bool RES_BF16> struct EpiOut {
    static constexpr bool PERM = true, AFTER_DRAIN = false, IDEMPOTENT = !RES_BF16;
    const float* res; bf16_t* xb; float* rowsq;
    __device__ __forceinline__ void operator()(const f32x4 (&acc)[2][2][4][2], const Unit& u, int wr, int wc, int fr, int fq) const {
        u32x4 rbv[2][4][2];
        if constexpr (RES_BF16) {
#pragma unroll
            for (int ai = 0; ai < 2; ++ai)
#pragma unroll
                for (int m = 0; m < 4; ++m) { const bf16_t* bp = xb + ((size_t)((u.pm * 4 + ai * 2 + wr) * 64 + u.pn * 8 + wc) * 2048 + (m * 16 + fr) * 32 + 8 * fq);
                    rbv[ai][m][0] = *(const u32x4*)bp; rbv[ai][m][1] = *(const u32x4*)(bp + 4 * 2048); }
            asm volatile("" ::: "memory"); }
        const int col0 = u.pn * BM + wc * 32 + 8 * fq;
#pragma unroll
        for (int ai = 0; ai < 2; ++ai)
#pragma unroll
            for (int m = 0; m < 4; ++m) { const int row = u.pm * BM + ai * HALF + wr * 64 + m * 16 + fr; float ss = 0.f;
                bf16_t* bp = xb + ((size_t)((u.pm * 4 + ai * 2 + wr) * 64 + u.pn * 8 + wc) * 2048 + (m * 16 + fr) * 32 + 8 * fq);
#pragma unroll
                for (int bj = 0; bj < 2; ++bj) { f32x4 r0, r1;
                    if constexpr (RES_BF16) { const u32x4 rb = rbv[ai][m][bj];
                        r0 = (f32x4){__uint_as_float(rb.x << 16), __uint_as_float(rb.x & 0xffff0000u), __uint_as_float(rb.y << 16), __uint_as_float(rb.y & 0xffff0000u)};
                        r1 = (f32x4){__uint_as_float(rb.z << 16), __uint_as_float(rb.z & 0xffff0000u), __uint_as_float(rb.w << 16), __uint_as_float(rb.w & 0xffff0000u)}; }
                    else { const float* rp = res + (size_t)row * 2048 + col0 + bj * HALF; r0 = *(const f32x4*)rp; r1 = *(const f32x4*)(rp + 4); }
                    const f32x4 v0 = r0 + acc[ai][bj][m][0], v1 = r1 + acc[ai][bj][m][1];
                    u32x4 w; w.x = cvt_pk_bf16(v0[0], v0[1]); w.y = cvt_pk_bf16(v0[2], v0[3]); w.z = cvt_pk_bf16(v1[0], v1[1]); w.w = cvt_pk_bf16(v1[2], v1[3]);
                    *(u32x4*)(bp + bj * 4 * 2048) = w;
                    ss += ((v0[0] * v0[0] + v0[1] * v0[1]) + (v0[2] * v0[2] + v0[3] * v0[3])) + ((v1[0] * v1[0] + v1[1] * v1[1]) + (v1[2] * v1[2] + v1[3] * v1[3])); }
                ss += __builtin_bit_cast(float, __builtin_amdgcn_ds_swizzle(__builtin_bit_cast(int, ss), (16 << 10) | 0x1F));
                { auto rr = __builtin_amdgcn_permlane32_swap(__float_as_uint(ss), __float_as_uint(ss), false, false); ss = __uint_as_float(rr[0]) + __uint_as_float(rr[1]); }
                if (fq == 0) rowsq[(size_t)row * 32 + u.pn * 4 + wc] = ss; }
    }
};

template <class Epi, class Sched, bool ALIGN_EPI = false, bool SP2 = false>
__device__ __forceinline__ void gemm_phase(PG8_LAS unsigned char* lds, const Gemm g, const Sched& S, const Epi& E, const int wave_id) {
    int lane_; asm volatile("v_mbcnt_lo_u32_b32 %0, -1, 0\n\tv_mbcnt_hi_u32_b32 %0, -1, %0" : "=v"(lane_));
    const int wid = wave_id, tid = wid * 64 + lane_, lane = lane_, wr = wid >> 2, wc = wid & 3, fr = lane & 15, fq = lane >> 4;
    const int K = g.K, nt = K / BK;
    unsigned voffA[2], voffB[2];
#pragma unroll
    for (int i = 0; i < 2; ++i) { int R, C; stage_rc(tid * 16 + i * 8192, R, C); const int Rb = Epi::PERM ? ((R & ~31) + perm32(R & 31)) : R;
        voffA[i] = (unsigned)(((R >> 6) * (K / 32) + (C >> 5)) * 2048 + (R & 63) * 32 + (C & 31)) * 2u; voffB[i] = (unsigned)(((Rb >> 6) * (K / 32) + (C >> 5)) * 2048 + (Rb & 63) * 32 + (C & 31)) * 2u; }
    const size_t kstep = (size_t)(2 * 2048 * 2);
    const size_t kstepA = (size_t)(2 * 2048 * 2);
    const size_t hstep = (size_t)HALF * K * 2;
    const size_t tstep = 2 * hstep;
    const unsigned ldsw = (unsigned)wid * 1024u;
    const int aoff = lds_byte(wr * 64 + fr, fq * 8), boff = lds_byte(wc * 32 + fr, fq * 8);
#define PG8_SA(b, h) (((b) * 2 + (h)) * HTB)
#define PG8_SB(b, h) ((4 + (b) * 2 + (h)) * HTB)
#define PG8_STAGE(bufoff, gbase, voff) do { _Pragma("unroll") for (int _i = 0; _i < 2; ++_i) \
        __builtin_amdgcn_global_load_lds((const unsigned*)((const char*)(gbase) + (voff)[_i]), (PG8_LAS unsigned*)(lds + (bufoff) + ldsw + _i * 8192), 16, 0, 0); } while (0)
#define PG8_LDA(dst, b, h) do { _Pragma("unroll") for (int m = 0; m < 4; ++m) _Pragma("unroll") for (int k = 0; k < 2; ++k) dst[m][k] = *(const PG8_LAS bf16x8*)(lds + PG8_SA(b, h) + aoff + m * 2048 + k * 1024); } while (0)
#define PG8_LDB(dst, b, h) do { _Pragma("unroll") for (int n = 0; n < 2; ++n) _Pragma("unroll") for (int k = 0; k < 2; ++k) dst[n][k] = *(const PG8_LAS bf16x8*)(lds + PG8_SB(b, h) + boff + n * 2048 + k * 1024); } while (0)
#define PG8_MMA(ai, bj, At, Bt) do { __builtin_amdgcn_s_setprio(1); _Pragma("unroll") for (int m = 0; m < 4; ++m) _Pragma("unroll") for (int n = 0; n < 2; ++n) _Pragma("unroll") for (int k = 0; k < 2; ++k) \
        acc[ai][bj][m][n] = __builtin_amdgcn_mfma_f32_16x16x32_bf16(Bt[n][k], At[m][k], acc[ai][bj][m][n], 0, 0, 0); __builtin_amdgcn_s_setprio(0); } while (0)
#define PG8_WAIT_V(n) asm volatile("s_waitcnt vmcnt(" #n ")" ::: "memory")
#define PG8_WAIT_L(n) asm volatile("s_waitcnt lgkmcnt(" #n ")" ::: "memory")
#define PG8_BAR __builtin_amdgcn_s_barrier()
#define PG8_SCHED __builtin_amdgcn_sched_barrier(0)
    Unit cur, nxt; int ui = 0;
    if (!S.next(0, cur)) return;
    f32x4 acc[2][2][4][2];
#pragma unroll
    for (int a = 0; a < 2; ++a)
#pragma unroll
        for (int b = 0; b < 2; ++b)
#pragma unroll
            for (int m = 0; m < 4; ++m)
#pragma unroll
                for (int n = 0; n < 2; ++n) acc[a][b][m][n] = (f32x4){0.f, 0.f, 0.f, 0.f};
    bf16x8 At[4][2], B0[2][2], B1[2][2];
    const char* cA = (const char*)g.A + (size_t)cur.pm * tstep; const char* cB = (const char*)g.Bt + (size_t)cur.pn * tstep;
    S.a_ready(cur);
    if constexpr (SP2) {
        PG8_STAGE(PG8_SB(0, 0), cB, voffB); PG8_STAGE(PG8_SB(0, 1), cB + hstep, voffB); PG8_STAGE(PG8_SA(0, 0), cA, voffA); PG8_STAGE(PG8_SA(0, 1), cA + hstep, voffA);
        if (wr == 1) PG8_BAR;
        PG8_WAIT_V(2); PG8_BAR;
        PG8_STAGE(PG8_SB(1, 0), cB + kstep, voffB); PG8_STAGE(PG8_SA(1, 0), cA + kstepA, voffA); PG8_STAGE(PG8_SB(1, 1), cB + hstep + kstep, voffB);
        PG8_WAIT_V(6); PG8_BAR;
    } else {
        PG8_STAGE(PG8_SB(0, 0), cB, voffB); PG8_STAGE(PG8_SA(0, 0), cA, voffA); PG8_STAGE(PG8_SB(0, 1), cB + hstep, voffB); PG8_STAGE(PG8_SA(0, 1), cA + hstep, voffA);
        if (wr == 1) PG8_BAR;
        PG8_WAIT_V(4); PG8_BAR;
        PG8_STAGE(PG8_SB(1, 0), cB + kstep, voffB); PG8_STAGE(PG8_SA(1, 0), cA + kstepA, voffA); PG8_STAGE(PG8_SB(1, 1), cB + hstep + kstep, voffB);
        PG8_WAIT_V(6); PG8_BAR;
    }
    for (;;) {
        const bool has_next = S.next(ui + 1, nxt);
        const char* nA = has_next ? (const char*)g.A + (size_t)nxt.pm * tstep : cA; const char* nB = has_next ? (const char*)g.Bt + (size_t)nxt.pn * tstep : cB;
        for (int t = 0; t < nt; t += 2) {
            const bool last = (t == nt - 2);
            const char* a1 = cA + (size_t)(t + 1) * kstepA;
            const char* a2 = last ? nA : cA + (size_t)(t + 2) * kstepA; const char* b2 = last ? nB : cB + (size_t)(t + 2) * kstep;
            const char* a3 = a2 + kstepA; const char* b3 = b2 + kstep;
            if (last && has_next) S.a_ready(nxt);
            if constexpr (SP2) {
            PG8_LDB(B0, 0, 0); PG8_LDB(B1, 0, 1); PG8_SCHED; PG8_LDA(At, 0, 0); PG8_STAGE(PG8_SA(1, 1), a1 + hstep, voffA);
            PG8_WAIT_V(8); PG8_WAIT_L(0); PG8_BAR; PG8_MMA(0, 0, At, B0); PG8_MMA(0, 1, At, B1); PG8_BAR; PG8_SCHED;
            PG8_LDA(At, 0, 1); PG8_STAGE(PG8_SB(0, 0), b2, voffB); PG8_STAGE(PG8_SB(0, 1), b2 + hstep, voffB); PG8_STAGE(PG8_SA(0, 0), a2, voffA);
            PG8_WAIT_V(8); PG8_WAIT_L(0); PG8_BAR; PG8_MMA(1, 0, At, B0); PG8_MMA(1, 1, At, B1); PG8_BAR; PG8_SCHED;
            PG8_LDB(B0, 1, 0); PG8_LDB(B1, 1, 1); PG8_SCHED; PG8_LDA(At, 1, 0); PG8_STAGE(PG8_SA(0, 1), a2 + hstep, voffA);
            PG8_WAIT_V(8); PG8_WAIT_L(0); PG8_BAR; PG8_MMA(0, 0, At, B0); PG8_MMA(0, 1, At, B1); PG8_BAR; PG8_SCHED;
            PG8_LDA(At, 1, 1); PG8_STAGE(PG8_SB(1, 0), b3, voffB); PG8_STAGE(PG8_SB(1, 1), b3 + hstep, voffB); PG8_STAGE(PG8_SA(1, 0), a3, voffA);
            PG8_WAIT_V(8); PG8_WAIT_L(0); PG8_BAR; PG8_MMA(1, 0, At, B0); PG8_MMA(1, 1, At, B1); PG8_BAR; PG8_SCHED;
            } else {
            PG8_LDB(B0, 0, 0); PG8_SCHED; PG8_LDA(At, 0, 0); PG8_STAGE(PG8_SA(1, 1), a1 + hstep, voffA);
            PG8_WAIT_L(8); PG8_BAR; PG8_WAIT_L(0); PG8_MMA(0, 0, At, B0); PG8_BAR; PG8_SCHED;
            PG8_LDB(B1, 0, 1); PG8_STAGE(PG8_SB(0, 0), b2, voffB);
            PG8_BAR; PG8_WAIT_L(0); PG8_MMA(0, 1, At, B1); PG8_BAR;
            PG8_LDA(At, 0, 1); PG8_STAGE(PG8_SA(0, 0), a2, voffA);
            PG8_BAR; PG8_WAIT_L(0); PG8_MMA(1, 0, At, B0); PG8_BAR; PG8_SCHED;
            PG8_STAGE(PG8_SB(0, 1), b2 + hstep, voffB);
            PG8_WAIT_V(6); PG8_BAR; PG8_MMA(1, 1, At, B1); PG8_BAR;
            PG8_LDB(B0, 1, 0); PG8_SCHED; PG8_LDA(At, 1, 0); PG8_STAGE(PG8_SA(0, 1), a2 + hstep, voffA);
            PG8_WAIT_L(8); PG8_BAR; PG8_WAIT_L(0); PG8_MMA(0, 0, At, B0); PG8_BAR; PG8_SCHED;
            PG8_LDB(B1, 1, 1); PG8_STAGE(PG8_SB(1, 0), b3, voffB);
            PG8_BAR; PG8_WAIT_L(0); PG8_MMA(0, 1, At, B1); PG8_BAR;
            PG8_LDA(At, 1, 1); PG8_STAGE(PG8_SA(1, 0), a3, voffA);
            PG8_BAR; PG8_WAIT_L(0); PG8_MMA(1, 0, At, B0); PG8_BAR; PG8_SCHED;
            PG8_STAGE(PG8_SB(1, 1), b3 + hstep, voffB);
            PG8_WAIT_V(6); PG8_BAR; PG8_MMA(1, 1, At, B1); PG8_BAR;
            }
        }
        if constexpr (ALIGN_EPI) { if (wr == 0) PG8_BAR; }
#ifndef REP_EPI
#define REP_EPI 1
#endif
        if constexpr (!Epi::AFTER_DRAIN) { for (int re_ = 0; re_ < (Epi::IDEMPOTENT ? REP_EPI : 1); ++re_) E(acc, cur, wr, wc, fr, fq); S.done(cur); }
        if (!has_next) break;
#pragma unroll
        for (int a = 0; a < 2; ++a)
#pragma unroll
            for (int b = 0; b < 2; ++b)
#pragma unroll
                for (int m = 0; m < 4; ++m)
#pragma unroll
                    for (int n = 0; n < 2; ++n) acc[a][b][m][n] = (f32x4){0.f, 0.f, 0.f, 0.f};
        cur = nxt; cA = nA; cB = nB; ++ui;
        if constexpr (ALIGN_EPI) { if (wr == 1) PG8_BAR; }
    }
    PG8_WAIT_V(0);
    if constexpr (!ALIGN_EPI) { if (wr == 0) PG8_BAR; }
    PG8_BAR;
    if constexpr (Epi::AFTER_DRAIN) { E.fused(acc, cur, wr, wc, fr, fq, lds, wid, lane); S.done(cur); }
#undef PG8_SA
#undef PG8_SB
#undef PG8_STAGE
#undef PG8_LDA
#undef PG8_LDB
#undef PG8_MMA
#undef PG8_WAIT_V
#undef PG8_WAIT_L
#undef PG8_BAR
#undef PG8_SCHED
}
}

#define LAS __attribute__((address_space(3)))
typedef unsigned short bf16_t;
typedef short bf16x8 __attribute__((ext_vector_type(8)));
typedef short s16x4 __attribute__((ext_vector_type(4)));
typedef float f32x4 __attribute__((ext_vector_type(4)));
typedef float f32x16 __attribute__((ext_vector_type(16)));
typedef unsigned u32x4 __attribute__((ext_vector_type(4)));
typedef unsigned u32x2 __attribute__((ext_vector_type(2)));

constexpr int BATCH = 4, SEQ = 4096, DM = 2048, M = BATCH * SEQ, NH = 8;
constexpr int IN_COLS = 8208, NPROJ = 8192;
constexpr size_t PJ_RB = 256 * 2048;
__host__ __device__ __forceinline__ size_t pj2(size_t row, int col) { return ((row >> 6) * 64 + (size_t)(col >> 5)) * 2048 + (row & 63) * 32 + (col & 31); }
__host__ __device__ __forceinline__ size_t pj(size_t row, int col) { return ((row >> 6) * 256 + (size_t)(col >> 5)) * 2048 + (row & 63) * 32 + (col & 31); }
constexpr int C_DAQ = 0, C_DAK = 1024, C_DAV = 2048, C_DAG = 3072, C_GQ = 4096, C_GK = 5120, C_GV = 6144, C_GZ = 7168;
constexpr float RMS_EPS = 1e-6f;
constexpr float LOG2E = 1.4426950408889634f;
constexpr float QSCALE = 0.125f * LOG2E;

constexpr size_t MiB = 1u << 20;
constexpr size_t WS_CTL = 0;
constexpr size_t WS_WIN = 1 * MiB;
constexpr size_t WS_WBA = 65 * MiB;
constexpr size_t WS_WOUT = 66 * MiB;
constexpr size_t WS_XB = 82 * MiB;
constexpr size_t WS_PROJ = 146 * MiB;
constexpr size_t WS_MIXED = 402 * MiB;
constexpr size_t WS_VN = 466 * MiB;
constexpr size_t WS_ROWSQ = 498 * MiB;
constexpr size_t WS_BA = 500 * MiB;
constexpr size_t WS_GB = 501 * MiB;
constexpr size_t WS_END = 502 * MiB;

constexpr int RING_BYTES = 131072;
constexpr int LDSX_OFF = RING_BYTES;
constexpr int LDS_BYTES = 163840;
constexpr int LDS_BARST = 163584;

__device__ __forceinline__ unsigned cvtpk(float lo, float hi) { unsigned r; asm volatile("v_cvt_pk_bf16_f32 %0, %1, %2" : "=v"(r) : "v"(lo), "v"(hi)); return r; }
__device__ __forceinline__ float bf_lo(unsigned w) { return __uint_as_float(w << 16); }
__device__ __forceinline__ float bf_hi(unsigned w) { return __uint_as_float(w & 0xffff0000u); }
template <int K> __device__ __forceinline__ float shx(float v) {
    const int x = __builtin_bit_cast(int, v);
    if constexpr (K == 1) return __builtin_bit_cast(float, __builtin_amdgcn_update_dpp(x, x, 0xB1, 0xF, 0xF, true));
    else if constexpr (K == 2) return __builtin_bit_cast(float, __builtin_amdgcn_update_dpp(x, x, 0x4E, 0xF, 0xF, true));
    else if constexpr (K == 32) { auto rr = __builtin_amdgcn_permlane32_swap((unsigned)x, (unsigned)x, false, false);
        return __builtin_bit_cast(float, (__builtin_amdgcn_mbcnt_hi(-1, 0) != 0) ? rr[0] : rr[1]); }
    else return __builtin_bit_cast(float, __builtin_amdgcn_ds_swizzle(x, (K << 10) | 0x1F));
}
__device__ __forceinline__ float rsum16(float v) {
    int x = __builtin_bit_cast(int, v); v += __builtin_bit_cast(float, __builtin_amdgcn_update_dpp(x, x, 0x128, 0xF, 0xF, true));
    x = __builtin_bit_cast(int, v); v += __builtin_bit_cast(float, __builtin_amdgcn_update_dpp(x, x, 0x124, 0xF, 0xF, true));
    x = __builtin_bit_cast(int, v); v += __builtin_bit_cast(float, __builtin_amdgcn_update_dpp(x, x, 0x4E, 0xF, 0xF, true));
    x = __builtin_bit_cast(int, v); v += __builtin_bit_cast(float, __builtin_amdgcn_update_dpp(x, x, 0xB1, 0xF, 0xF, true));
    return v; }
__device__ __forceinline__ float sum32(float v) { auto rr = __builtin_amdgcn_permlane32_swap(__float_as_uint(v), __float_as_uint(v), false, false); return __uint_as_float(rr[0]) + __uint_as_float(rr[1]); }
__device__ __forceinline__ float wave_sum(float v) { v += shx<1>(v); v += shx<2>(v); v += shx<4>(v); v += shx<8>(v); v += shx<16>(v); return sum32(v); }
__device__ __forceinline__ float frcp(float x) { return __builtin_amdgcn_rcpf(x); }
__device__ __forceinline__ float frsq(float x) { return __builtin_amdgcn_rsqf(x); }
__device__ __forceinline__ float silu_f(float x) { return x * frcp(1.f + __expf(-x)); }

#ifndef REP_P0
#define REP_P0 1
#endif
#ifndef REP_P1
#define REP_P1 1
#endif
#ifndef REP_CONV
#define REP_CONV 1
#endif
#ifndef REP_ATT
#define REP_ATT 1
#endif
#ifndef REP_SCAN
#define REP_SCAN 1
#endif
#ifndef REP_P3
#define REP_P3 1
#endif
#ifndef PG8_SP2_ALL
#define PG8_SP2_ALL true
#endif
#ifndef PG8_ALIGN_P1
#define PG8_ALIGN_P1 true
#endif
struct Args { const float* in[15]; float* out; unsigned char* ws; };

struct Ctx {
    int tid, lane, wave, bid, G;
    const float *x, *norm_w, *w_in, *w_out, *lq1, *lk1, *lq2, *lk2, *subln_w, *rel_bias, *conv_w, *a_log, *dt_bias, *gdn_norm_w, *final_w;
    float* out; unsigned char* ws;
};

__device__ __forceinline__ int fresh_tid(int wave) { int l; asm volatile("v_mbcnt_lo_u32_b32 %0, -1, 0\n\tv_mbcnt_hi_u32_b32 %0, -1, %0" : "=v"(l)); return wave * 64 + l; }
__device__ __forceinline__ void relaunder(Ctx& F) { const int t = fresh_tid(F.wave); F.tid = t; F.lane = t & 63; }

__device__ __forceinline__ void p0_transpose_item(const float* W, int K, int N, const float* kscale, bf16_t* WT, int Nmain, bf16_t* WT2, LAS float* scr, int item, int lane) {
    const int nblk = (N + 63) / 64, kb = item / nblk, nb = item % nblk, k0 = 64 * kb, n0 = 64 * nb;
    const int nn = n0 + (lane & 15) * 4;
    f32x4 v[16];
#pragma unroll
    for (int i = 0; i < 16; ++i) { const int kk = 4 * i + (lane >> 4); v[i] = (nn < N) ? *(const f32x4*)(W + (size_t)(k0 + kk) * N + nn) : (f32x4){0.f, 0.f, 0.f, 0.f}; }
#pragma unroll
    for (int i = 0; i < 16; ++i) { const int kk = 4 * i + (lane >> 4); const float ks = kscale ? kscale[k0 + kk] : 1.f; LAS float* d = scr + kk * 65 + (lane & 15) * 4;
        d[0] = v[i][0] * ks; d[1] = v[i][1] * ks; d[2] = v[i][2] * ks; d[3] = v[i][3] * ks; }
    asm volatile("s_waitcnt lgkmcnt(0)" ::: "memory");
    const int c = lane & 7;
#pragma unroll
    for (int j = 0; j < 8; ++j) { const int n = (lane >> 3) + 8 * j; const LAS float* s = scr + (8 * c) * 65 + n;
        u32x4 o; o.x = cvtpk(s[0 * 65], s[1 * 65]); o.y = cvtpk(s[2 * 65], s[3 * 65]); o.z = cvtpk(s[4 * 65], s[5 * 65]); o.w = cvtpk(s[6 * 65], s[7 * 65]);
        const int ng = n0 + n;
        if (ng < Nmain) *(u32x4*)(WT + (((size_t)(ng >> 6) * (K / 32) + ((k0 + 8 * c) >> 5)) * 2048 + (ng & 63) * 32 + ((k0 + 8 * c) & 31))) = o;
        else if (ng < N) *(u32x4*)(WT2 + (size_t)(ng - Nmain) * K + k0 + 8 * c) = o; }
    asm volatile("s_waitcnt lgkmcnt(0)" ::: "memory");
}
constexpr int P0_I_IN = (DM / 64) * ((IN_COLS + 63) / 64), P0_I_OUT = (DM / 64) * (DM / 64), P0_LAYER_ITEMS = P0_I_IN + P0_I_OUT;
__device__ __forceinline__ void p0_weight_item(Ctx& F, LAS float* scr, int l, int r) {
    if (r < P0_I_IN) p0_transpose_item(F.w_in + (size_t)l * DM * IN_COLS, DM, IN_COLS, F.norm_w + l * DM, (bf16_t*)(F.ws + WS_WIN) + (size_t)l * NPROJ * DM, NPROJ,
                                       (bf16_t*)(F.ws + WS_WBA) + (size_t)l * 16 * DM, scr, r, F.lane);
    else p0_transpose_item(F.w_out + (size_t)l * DM * DM, DM, DM, nullptr, (bf16_t*)(F.ws + WS_WOUT) + (size_t)l * DM * DM, DM, nullptr, scr, r - P0_I_IN, F.lane);
}
__device__ __forceinline__ void p0_prologue(Ctx& F, LAS unsigned char* lds) {
    LAS float* scr = (LAS float*)(lds + F.wave * 17408);
    const int gw = F.bid * 8 + F.wave, NGW = F.G * 8;
    for (int it = gw; it < P0_LAYER_ITEMS; it += NGW) p0_weight_item(F, scr, 0, it);
    bf16_t* XB = (bf16_t*)(F.ws + WS_XB); float* RQ = (float*)(F.ws + WS_ROWSQ);
    for (int m = gw; m < M; m += NGW) {
        const f32x4* xr = (const f32x4*)(F.x + (size_t)m * DM) + F.lane; float ss = 0.f;
        bf16_t* xbrow = XB + pj2((size_t)m, 4 * F.lane);
        f32x4 xv8[8];
#pragma unroll
        for (int j = 0; j < 8; ++j) xv8[j] = xr[64 * j];
#pragma unroll
        for (int j = 0; j < 8; ++j) { const f32x4 v = xv8[j]; ss += (v[0] * v[0] + v[1] * v[1]) + (v[2] * v[2] + v[3] * v[3]); u32x2 w; w.x = cvtpk(v[0], v[1]); w.y = cvtpk(v[2], v[3]); *(u32x2*)(xbrow + (size_t)j * 8 * 2048) = w; }
        ss = wave_sum(ss);
        if (F.lane < 32) RQ[(size_t)m * 32 + F.lane] = (F.lane == 0) ? ss : 0.f;
    }
}

__device__ __forceinline__ void rstd_table(Ctx& F, LAS float* tab, int row0, int nrows) {
    const float* RQ = (const float*)(F.ws + WS_ROWSQ);
    const int r = F.tid >> 1, hf = F.tid & 1;
    float s = 0.f;
    if (r < nrows) { const f32x4* p = (const f32x4*)(RQ + (size_t)(row0 + r) * 32 + hf * 16);
#pragma unroll
        for (int i = 0; i < 4; ++i) { const f32x4 v = p[i]; s += (v[0] + v[1]) + (v[2] + v[3]); } }
    s += shx<1>(s);
    if (r < nrows && hf == 0) tab[r] = frsq(s * (1.0f / DM) + RMS_EPS);
}

__device__ __forceinline__ void ba_job(Ctx& F, LAS unsigned char* lds, int layer) {
    const bf16_t* XB = (const bf16_t*)(F.ws + WS_XB); const bf16_t* WB = (const bf16_t*)(F.ws + WS_WBA) + (size_t)layer * 16 * DM;
    float* BA = (float*)(F.ws + WS_BA);
    const int row0 = F.bid * 64; if (row0 >= M) return;
    LAS float* rs = (LAS float*)(lds + 65536);
    const int fr = F.lane & 15, fq = F.lane >> 4, k0 = F.wave * 256;
    bf16x8 bfr[8], afr[8][4];
#pragma unroll
    for (int s = 0; s < 8; ++s) { const int k = k0 + s * 32 + fq * 8;
        bfr[s] = *(const bf16x8*)(WB + (size_t)fr * DM + k);
#pragma unroll
        for (int rb = 0; rb < 4; ++rb) afr[s][rb] = *(const bf16x8*)(XB + pj2((size_t)(row0 + rb * 16 + fr), k)); }
    asm volatile("" ::: "memory");
    rstd_table(F, rs, row0, 64);
    f32x4 acc[4] = {};
#pragma unroll
    for (int s = 0; s < 8; ++s)
#pragma unroll
        for (int rb = 0; rb < 4; ++rb) acc[rb] = __builtin_amdgcn_mfma_f32_16x16x32_bf16(afr[s][rb], bfr[s], acc[rb], 0, 0, 0);
    LAS float* red = (LAS float*)lds + F.wave * 1024;
#pragma unroll
    for (int rb = 0; rb < 4; ++rb)
#pragma unroll
        for (int i = 0; i < 4; ++i) red[(rb * 16 + fq * 4 + i) * 16 + fr] = acc[rb][i];
    __syncthreads();
    for (int e = F.tid; e < 1024; e += 512) { float s = 0.f;
#pragma unroll
        for (int w = 0; w < 8; ++w) s += ((LAS float*)lds)[w * 1024 + e];
        BA[(size_t)row0 * 16 + e] = s * rs[e >> 4]; }
    __syncthreads();
}

namespace att {
constexpr int QB = 256, KVBLK = 64;
constexpr int SHM_V = 16384, SHM_K = 16384;
constexpr int OFF_V = 0, OFF_K = SHM_V, BUF2 = SHM_V + SHM_K, OFF_Q = 2 * BUF2;
constexpr int OFF_TAB = LDSX_OFF + 4096, OFF_WS = LDSX_OFF + 4096 + 2048;
constexpr int OFF_V2 = LDSX_OFF + 8192;
constexpr float SM_THR = 6.0f;
constexpr int NMAXT = 255;
#define KSWZ(row, colB) ((row) * 256 + ((colB) ^ (((row) & 7) << 4)))
#define SBAR() __builtin_amdgcn_sched_barrier(0)
__device__ __forceinline__ int v_st(int k, int c) { const int kk = (k & ~0xC) | ((k & 4) << 1) | ((k & 8) >> 1); return ((kk >> 3) * 4 + (c >> 5)) * 512 + ((kk & 7) * 32 + (c & 31)) * 2; }
__device__ __forceinline__ int v_rd_base(int lane) { return ((lane & 3) << 3) | (((lane >> 2) & 3) << 6) | (((lane >> 4) & 1) << 5) | (((lane >> 5) & 1) << 8); }
constexpr int v_rd_off(int d0, int ks, int half) { return d0 * 512 + ks * 4096 + half * 2048; }
__device__ __forceinline__ int crow(int r, int hi) { return (r & 3) + 8 * (r >> 2) + 4 * hi; }

__constant__ const unsigned char T5_BUCKET[113] = {0, 1, 2, 3, 4, 5, 6, 7, 8, 9, 10, 11, 12, 13, 14, 15, 16, 16, 16, 17, 17, 18, 18, 18, 19, 19, 19, 20, 20, 20, 20, 21, 21, 21, 21, 22, 22, 22, 22, 22, 23, 23, 23, 23, 23, 23,
    24, 24, 24, 24, 24, 24, 25, 25, 25, 25, 25, 25, 25, 26, 26, 26, 26, 26, 26, 26, 26, 27, 27, 27, 27, 27, 27, 27, 27, 27, 27, 28, 28, 28, 28, 28, 28, 28, 28, 28, 28, 29, 29, 29, 29, 29, 29, 29, 29, 29, 29, 29, 29,
    30, 30, 30, 30, 30, 30, 30, 30, 30, 30, 30, 30, 30, 30};

template <int KOFF> __device__ __forceinline__ void qkt(f32x16& p0, f32x16& p1, const unsigned* ka, const unsigned* qa, int mp) {
    p0 = f32x16{}; p1 = f32x16{};
#pragma unroll
    for (int dd = 0; dd < 4; ++dd) {
        const LAS char* a = (const LAS char*)(uintptr_t)ka[dd] + mp * 128 + KOFF; const LAS char* q = (const LAS char*)(uintptr_t)qa[dd] + mp * 128;
        const bf16x8 b0 = *reinterpret_cast<const LAS bf16x8*>(a);
        const bf16x8 b1 = *reinterpret_cast<const LAS bf16x8*>(a + 32 * 256);
        const bf16x8 qf = *reinterpret_cast<const LAS bf16x8*>(q);
        p0 = __builtin_amdgcn_mfma_f32_32x32x16_bf16(b0, qf, p0, 0, 0, 0);
        p1 = __builtin_amdgcn_mfma_f32_32x32x16_bf16(b1, qf, p1, 0, 0, 0); }
}
template <int VOFF> __device__ __forceinline__ void pv_tile(f32x16* o, int vb0, bf16x8 pa0, bf16x8 pa1, bf16x8 pa2, bf16x8 pa3) {
#define TRRD(dst, off) asm volatile("ds_read_b64_tr_b16 %0, %1 offset:%2" : "=&v"(dst) : "v"(vb0), "i"(off) : "memory")
#define PV_D0(d0) do { s16x4 l0, l1, l2, l3, h0, h1, h2, h3; constexpr int b_ = VOFF + v_rd_off(d0, 0, 0); \
        TRRD(l0, b_); TRRD(h0, b_ + 2048); TRRD(l1, b_ + 4096); TRRD(h1, b_ + 6144); TRRD(l2, b_ + 8192); TRRD(h2, b_ + 10240); TRRD(l3, b_ + 12288); TRRD(h3, b_ + 14336); \
        asm volatile("s_waitcnt lgkmcnt(0)" ::: "memory"); SBAR(); \
        o[d0] = __builtin_amdgcn_mfma_f32_32x32x16_bf16(pa0, (bf16x8){l0[0], l0[1], l0[2], l0[3], h0[0], h0[1], h0[2], h0[3]}, o[d0], 0, 0, 0); \
        o[d0] = __builtin_amdgcn_mfma_f32_32x32x16_bf16(pa1, (bf16x8){l1[0], l1[1], l1[2], l1[3], h1[0], h1[1], h1[2], h1[3]}, o[d0], 0, 0, 0); \
        o[d0] = __builtin_amdgcn_mfma_f32_32x32x16_bf16(pa2, (bf16x8){l2[0], l2[1], l2[2], l2[3], h2[0], h2[1], h2[2], h2[3]}, o[d0], 0, 0, 0); \
        o[d0] = __builtin_amdgcn_mfma_f32_32x32x16_bf16(pa3, (bf16x8){l3[0], l3[1], l3[2], l3[3], h3[0], h3[1], h3[2], h3[3]}, o[d0], 0, 0, 0); } while (0)
    PV_D0(0); PV_D0(1); PV_D0(2); PV_D0(3);
#undef PV_D0
#undef TRRD
}
__device__ __forceinline__ void softmax_tile(f32x16& p0, f32x16& p1, float& m_reg, float& l_reg, f32x16* o, float* al_l, int r32, int hi,
                                             bf16x8& pa0, bf16x8& pa1, bf16x8& pa2, bf16x8& pa3) {
    float pmax = p0[0];
#pragma unroll
    for (int r = 1; r < 16; ++r) pmax = fmaxf(pmax, p0[r]);
#pragma unroll
    for (int r = 0; r < 16; ++r) pmax = fmaxf(pmax, p1[r]);
    { auto rr = __builtin_amdgcn_permlane32_swap(__float_as_uint(pmax), __float_as_uint(pmax), false, false);
      pmax = fmaxf(__uint_as_float(rr[0]), __uint_as_float(rr[1])); }
    const float mn = fmaxf(m_reg, pmax);
    if (__any(pmax > m_reg + SM_THR)) {
        const float alpha = __builtin_amdgcn_exp2f(m_reg - mn);
        l_reg *= alpha; m_reg = mn;
        if (hi == 0) al_l[r32] = alpha;
        asm volatile("s_waitcnt lgkmcnt(0)" ::: "memory");
#pragma unroll
        for (int d_ = 0; d_ < 4; ++d_)
#pragma unroll
            for (int r = 0; r < 16; ++r) o[d_][r] *= al_l[crow(r, hi)];
    }
#pragma unroll
    for (int r = 0; r < 16; ++r) { p0[r] = __builtin_amdgcn_exp2f(p0[r] - m_reg); p1[r] = __builtin_amdgcn_exp2f(p1[r] - m_reg); }
    float ps = 0.f;
#pragma unroll
    for (int r = 0; r < 16; ++r) ps += p0[r];
#pragma unroll
    for (int r = 0; r < 16; ++r) ps += p1[r];
    { auto rr = __builtin_amdgcn_permlane32_swap(__float_as_uint(ps), __float_as_uint(ps), false, false);
      ps = __uint_as_float(rr[0]) + __uint_as_float(rr[1]); }
    l_reg += ps;
#define PK4(P, B_, OUT) do { unsigned a0 = cvtpk(P[B_+0], P[B_+1]), a1 = cvtpk(P[B_+2], P[B_+3]); \
        unsigned b0 = cvtpk(P[B_+4], P[B_+5]), b1 = cvtpk(P[B_+6], P[B_+7]); \
        auto r0 = __builtin_amdgcn_permlane32_swap(a0, b0, false, false); auto r1 = __builtin_amdgcn_permlane32_swap(a1, b1, false, false); \
        u32x4 w = {r0[0], r1[0], r0[1], r1[1]}; OUT = *reinterpret_cast<bf16x8*>(&w); } while (0)
    PK4(p0, 0, pa0); PK4(p0, 8, pa1); PK4(p1, 0, pa2); PK4(p1, 8, pa3);
#undef PK4
}

template <bool ISY> __device__ __forceinline__ void attn_unit(Ctx& F, char* lds, int layer, int b, int h, int qb, float lam, float one_minus_li, unsigned* wqp, volatile LAS unsigned* wqlp) {
    const int tid_ = fresh_tid(F.wave);
    const int tid = tid_, wid = F.wave, lane = tid & 63, r32 = lane & 31, hi = lane >> 5;
    const bf16_t* PROJ = (const bf16_t*)(F.ws + WS_PROJ); bf16_t* MIXED = (bf16_t*)(F.ws + WS_MIXED);
    const long rowbase = (long)b * SEQ; const int q0 = qb * QB;
    char* V_lds = lds + OFF_V; char* K_lds = lds + OFF_K;
    float* tab = (float*)(lds + OFF_TAB); float* al_l = (float*)(lds + OFF_WS) + wid * 64;
    char* Qw_lds = lds + OFF_Q + wid * 8192;
    const int sr = tid >> 4, sc = (tid & 15) * 8;
    const bf16_t* Kg = PROJ + pj((size_t)rowbase + sr, C_DAK + h * 128 + sc);
    const bf16_t* Vg = PROJ + pj((size_t)rowbase + sr, C_DAV + h * 128 + sc);
    bf16x8 st_k0, st_k1, st_v0, st_v1;
    { const int nb_ = NMAXT - tid;
      const float b31 = F.rel_bias[31 * NH + h];
      const float bv_ = (nb_ >= 0 && nb_ < 113) ? F.rel_bias[(int)T5_BUCKET[nb_] * NH + h] : b31;
      bf16x8 qv_[8];
      const size_t qrow0 = (size_t)(rowbase + q0 + wid * 32);
#pragma unroll
      for (int i = 0; i < 8; ++i) { const int e = i * 64 + lane, row = e >> 4, c8 = (e & 15) * 8; qv_[i] = *reinterpret_cast<const bf16x8*>(PROJ + pj(qrow0 + row, C_DAQ + h * 128 + c8)); }
      st_k0 = *(const bf16x8*)(Kg); st_k1 = *(const bf16x8*)(Kg + (size_t)1024); st_v0 = *(const bf16x8*)(Vg); st_v1 = *(const bf16x8*)(Vg + (size_t)1024);
      asm volatile("" ::: "memory");
      tab[tid] = (nb_ < 0) ? -__builtin_inff() : (bv_ - b31) * LOG2E;
#pragma unroll
      for (int i = 0; i < 8; ++i) { const int e = i * 64 + lane, row = e >> 4, c8 = (e & 15) * 8; *(bf16x8*)(Qw_lds + KSWZ(row, c8 * 2)) = qv_[i]; } }
    const int vst0 = v_st(sr, sc), vst1 = v_st(32 + sr, sc), kws = KSWZ(sr, sc * 2);
    const int vb0 = (int)(uintptr_t)V_lds + v_rd_base(lane);
    unsigned ka[4], qa[4];
#pragma unroll
    for (int dd = 0; dd < 4; ++dd) { const unsigned o_ = (unsigned)KSWZ(r32, (dd * 16 + hi * 8) * 2); ka[dd] = (unsigned)(uintptr_t)K_lds + o_; qa[dd] = (unsigned)(uintptr_t)Qw_lds + o_; }
    const int NT = (q0 + QB) / KVBLK;
    const int qlo = q0 + wid * 32;
    float m1 = -1e30f, l1 = 0.f, m2 = -1e30f, l2 = 0.f;
    f32x16 o1[4] = {}, o2[4] = {};
#define SLOAD(t) do { const size_t o_ = (size_t)(t) * PJ_RB; st_k0 = *(const bf16x8*)(Kg + o_); st_k1 = *(const bf16x8*)(Kg + o_ + (size_t)1024); \
                      st_v0 = *(const bf16x8*)(Vg + o_); st_v1 = *(const bf16x8*)(Vg + o_ + (size_t)1024); } while (0)
#define SWRITE(BO, VO) do { *(bf16x8*)(K_lds + (BO) + kws) = st_k0; *(bf16x8*)(K_lds + (BO) + kws + 32 * 256) = st_k1; *(bf16x8*)(lds + (VO) + vst0) = st_v0; *(bf16x8*)(lds + (VO) + vst1) = st_v1; } while (0)
    constexpr bool isY = ISY;
    bool pend = false;
    int vo_prev = OFF_V2, vo_cur = 0, vo_nxt = BUF2;
    bf16x8 pp0, pp1, pp2, pp3;
#define ASTEP(t, CUR, NXT) do { \
        if ((t) + 1 < NT) { SWRITE((NXT) * BUF2, vo_nxt); } \
        if ((t) + 2 < NT) { SLOAD((t) + 2); } \
        if (isY && pend) { asm volatile("" ::: "memory"); pv_tile<0>(o2, vb0 + vo_prev, pp0, pp1, pp2, pp3); pend = false; SBAR(); } \
        const int kb = (t) * KVBLK; \
        if (kb <= qlo + 31) {                                \
        const bool band = (qlo - kb - 63) < 113;             \
        const int jb = NMAXT - (qlo + r32 - kb) + 4 * hi;    \
        { f32x16 p0, p1, s0, s1; bf16x8 pa0, pa1, pa2, pa3; \
            asm volatile("" ::: "memory"); \
            qkt<(CUR) * BUF2>(p0, p1, ka, qa, 0); \
            asm volatile("" ::: "memory"); \
            if (band) { _Pragma("unroll") for (int r = 0; r < 16; ++r) { const int c = (r & 3) + 8 * (r >> 2); p0[r] += tab[jb + c]; p1[r] += tab[jb + 32 + c]; } } \
            asm volatile("" ::: "memory"); \
            softmax_tile(p0, p1, m1, l1, o1, al_l, r32, hi, pa0, pa1, pa2, pa3); SBAR(); \
            qkt<(CUR) * BUF2>(s0, s1, ka, qa, 1); SBAR(); \
            pv_tile<0>(o1, vb0 + vo_cur, pa0, pa1, pa2, pa3); SBAR(); \
            if (band) { _Pragma("unroll") for (int r = 0; r < 16; ++r) { const int c = (r & 3) + 8 * (r >> 2); s0[r] += tab[jb + c]; s1[r] += tab[jb + 32 + c]; } } \
            asm volatile("" ::: "memory"); \
            softmax_tile(s0, s1, m2, l2, o2, al_l, r32, hi, pp0, pp1, pp2, pp3); SBAR(); \
            if (isY) pend = true; else pv_tile<0>(o2, vb0 + vo_cur, pp0, pp1, pp2, pp3); \
        } } \
        asm volatile("s_waitcnt lgkmcnt(0)" ::: "memory"); __builtin_amdgcn_s_barrier(); asm volatile("" ::: "memory");        \
        { const int tmp_ = vo_prev; vo_prev = vo_cur; vo_cur = vo_nxt; vo_nxt = tmp_; } } while (0)
    SWRITE(0, 0); SLOAD(1);
    __syncthreads();
#pragma unroll 1
    for (int t = 0; t < NT; t += 2) { ASTEP(t, 0, 1); ASTEP(t + 1, 1, 0); }
    if (isY && pend) { asm volatile("" ::: "memory"); pv_tile<0>(o2, vb0 + vo_prev, pp0, pp1, pp2, pp3); }
#undef SLOAD
#undef SWRITE
#undef ASTEP
    __syncthreads();
    unsigned nxt_ = 0u; if (tid == 0) nxt_ = __hip_atomic_fetch_add(wqp, 1u, __ATOMIC_RELAXED, __HIP_MEMORY_SCOPE_AGENT);
    { float* stg = (float*)(lds + wid * 16384);
      const int row = lane >> 1, hf = lane & 1;
      const size_t grow = (size_t)(rowbase + q0 + wid * 32 + row);
      const bf16_t* gp = PROJ + pj(grow, C_DAG + h * 128 + hf * 64);
      u32x4 g8[8];
#pragma unroll
      for (int i = 0; i < 8; ++i) g8[i] = *(const u32x4*)(gp + (i >> 2) * 2048 + (i & 3) * 8);
      asm volatile("" ::: "memory");
      if (hi == 0) { al_l[r32] = frcp(l1); al_l[32 + r32] = lam * frcp(l2); }
      asm volatile("s_waitcnt lgkmcnt(0)" ::: "memory");
#pragma unroll
      for (int r = 0; r < 16; ++r) { const int orow = crow(r, hi); const float a = al_l[orow], bb = al_l[32 + orow];
#pragma unroll
          for (int d0 = 0; d0 < 4; ++d0) stg[orow * 128 + d0 * 32 + r32] = o1[d0][r] * a - o2[d0][r] * bb; }
      asm volatile("s_waitcnt lgkmcnt(0)" ::: "memory");
      const f32x4* sp = (const f32x4*)(stg + row * 128 + hf * 64);
      float ss = 0.f;
#pragma unroll
      for (int i = 0; i < 16; ++i) { const f32x4 t4 = sp[i]; ss += (t4[0] * t4[0] + t4[1] * t4[1]) + (t4[2] * t4[2] + t4[3] * t4[3]); }
      ss += shx<1>(ss);
      int ly_ = layer; asm volatile("" : "+s"(ly_));
      const float rs = ((ly_ == 0) ? 0.8f : 1.0f - 0.35550906759f) * frsq(ss * (1.0f / 128.0f) + RMS_EPS);
      bf16_t* op = MIXED + pj2(grow, h * 128 + hf * 64);
      const float* sw = F.subln_w + layer * 128 + hf * 64;
#pragma unroll 2
      for (int i = 0; i < 8; ++i) { const u32x4 g = g8[i]; const f32x4 w0 = *(const f32x4*)(sw + i * 8), w1 = *(const f32x4*)(sw + i * 8 + 4);
          const f32x4 a = sp[2 * i], c = sp[2 * i + 1]; u32x4 o;
          o.x = cvtpk(a[0] * rs * w0[0] * bf_lo(g.x), a[1] * rs * w0[1] * bf_hi(g.x));
          o.y = cvtpk(a[2] * rs * w0[2] * bf_lo(g.y), a[3] * rs * w0[3] * bf_hi(g.y));
          o.z = cvtpk(c[0] * rs * w1[0] * bf_lo(g.z), c[1] * rs * w1[1] * bf_hi(g.z));
          o.w = cvtpk(c[2] * rs * w1[2] * bf_lo(g.w), c[3] * rs * w1[3] * bf_hi(g.w));
          *(u32x4*)(op + (i >> 2) * 2048 + (i & 3) * 8) = o; }
    }
    if (tid == 0) wqlp[0] = nxt_;
    __syncthreads();
}

#undef SBAR
}

namespace gdn {
constexpr int WAVE_LDS = 18432;
constexpr int LT_PITCH = 144;
__host__ __device__ constexpr int ro4(int i) { return i == 0 ? 0 : 4 * ((((i - 1) / 4) + 1) * (2 * ((i - 1) / 4) + (i - 4 * ((i - 1) / 4)) - 1)); }
using att::v_st; using att::v_rd_base; using att::v_rd_off; using att::crow;

#define MKRS(p) __builtin_amdgcn_make_buffer_rsrc((void*)(p), 0, 0x02000000, 0x00020000)
typedef unsigned v4u_t __attribute__((__vector_size__(16)));
__device__ __forceinline__ u32x4 bld128(__amdgpu_buffer_rsrc_t r, unsigned vo, unsigned so) { return __builtin_bit_cast(u32x4, __builtin_amdgcn_raw_buffer_load_b128(r, vo, so, 0)); }
__device__ __forceinline__ void bst128(u32x4 v, __amdgpu_buffer_rsrc_t r, unsigned vo, unsigned so) { __builtin_amdgcn_raw_buffer_store_b128(__builtin_bit_cast(v4u_t, v), r, vo, so, 0); }
__device__ __forceinline__ bf16_t* wbuf(Ctx& F) { return (bf16_t*)((char*)F.out + 64 * MiB); }
__device__ __forceinline__ bf16_t* qkbuf(Ctx& F) { return (bf16_t*)((char*)F.out + 96 * MiB); }
__device__ __forceinline__ void chunk_prep(Ctx& F, char* wl, int layer, int item) {
    const int tid_ = fresh_tid(F.wave);
    const int lane = tid_ & 63, r32 = lane & 31, hi = lane >> 5;
    const int n = item & 63, bh = item >> 6, b = bh >> 3, h = bh & 7;
    const size_t m0 = (size_t)b * SEQ + (size_t)n * 64;
    bf16_t* QN = (bf16_t*)F.out; bf16_t* KN = (bf16_t*)((char*)F.out + 32 * MiB); bf16_t* VN = (bf16_t*)(F.ws + WS_VN);
    float* GB = (float*)(F.ws + WS_GB); const float* BA = (const float*)(F.ws + WS_BA); const bf16_t* PROJ = (const bf16_t*)(F.ws + WS_PROJ);
    const __amdgpu_buffer_rsrc_t rsQ = MKRS(QN + m0 * 1024 + h * 128), rsK = MKRS(KN + m0 * 1024 + h * 128), rsV = MKRS(VN + m0 * 1024 + h * 128);
    const unsigned offS = (unsigned)(((lane >> 4) * 1024 + (lane & 15) * 8) * 2);
    float* Lp = (float*)wl; char* Tl = wl; char* stg = wl + 9216; float* Gt = (float*)(wl + 17408); float* Bt = Gt + 64;
    const int g4 = lane >> 4, c8 = (lane & 15) * 8;
    const bool zero_hist = (n == 0) && (g4 == 0);
    const bf16_t* src0 = PROJ + pj(m0 + 16 * g4, C_GQ + h * 128 + c8);
    const bf16_t* hsrc0 = (g4 == 0) ? (src0 - PJ_RB + 64 * 32) : src0;
    const float* cw0 = F.conv_w + (size_t)layer * 4 * 3072 + h * 128 + c8;
    typedef float f32x2_t __attribute__((ext_vector_type(2)));
    u32x4 rawA[8], rawB[8], hal[3]; f32x2_t wA[4][4], wB[4][4];
#define UNPK(dstv, u) do { dstv[0] = (f32x2_t){bf_lo(u.x), bf_hi(u.x)}; dstv[1] = (f32x2_t){bf_lo(u.y), bf_hi(u.y)}; dstv[2] = (f32x2_t){bf_lo(u.z), bf_hi(u.z)}; dstv[3] = (f32x2_t){bf_lo(u.w), bf_hi(u.w)}; } while (0)
#define CLOAD(t, R, blk) do { _Pragma("unroll") for (int j_ = 0; j_ < 8; ++j_) R[j_] = *(const u32x4*)(src0 + (t) * 32 * 2048 + ((blk) * 8 + j_) * 32); } while (0)
#define CLOADH(t) do { hal[0] = *(const u32x4*)(hsrc0 + (t) * 32 * 2048 - 1 * 32); hal[1] = *(const u32x4*)(hsrc0 + (t) * 32 * 2048 - 2 * 32); hal[2] = *(const u32x4*)(hsrc0 + (t) * 32 * 2048 - 3 * 32); } while (0)
#define CLOADW(t, W) do { _Pragma("unroll") for (int j = 0; j < 4; ++j) { const f32x4 a = *(const f32x4*)(cw0 + j * 3072 + (t) * 1024), bb = *(const f32x4*)(cw0 + j * 3072 + (t) * 1024 + 4); \
          W[j][0] = (f32x2_t){a[0], a[1]}; W[j][1] = (f32x2_t){a[2], a[3]}; W[j][2] = (f32x2_t){bb[0], bb[1]}; W[j][3] = (f32x2_t){bb[2], bb[3]}; } } while (0)
#define CFENCE() asm volatile("" ::: "memory")
    CLOADH(0); CLOAD(0, rawA, 0); CLOAD(0, rawB, 1); CLOADW(0, wA);
    CFENCE();
    { const float braw = BA[(m0 + lane) * 16 + h], araw = BA[(m0 + lane) * 16 + 8 + h] + F.dt_bias[layer * NH + h];
      const float sp = fmaxf(araw, 0.f) + __logf(1.f + __expf(-fabsf(araw)));
      const float g = -__expf(F.a_log[layer * NH + h]) * sp, beta = frcp(1.f + __expf(-braw));
      Gt[lane] = g; asm volatile("s_waitcnt lgkmcnt(0)" ::: "memory");
      float Gc = 0.f;
#pragma unroll 8
      for (int m = 0; m < 64; ++m) { const float gm = Gt[m]; Gc += (m <= lane) ? gm : 0.f; }
      asm volatile("s_waitcnt lgkmcnt(0)" ::: "memory");
      Gt[lane] = Gc; Bt[lane] = beta; GB[(m0 + lane) * 16 + h] = Gc;
      asm volatile("s_waitcnt lgkmcnt(0)" ::: "memory"); }
    f32x2_t x1[4], x2[4], x3[4];
    {
#define CINIT() do { UNPK(x1, hal[0]); UNPK(x2, hal[1]); UNPK(x3, hal[2]); \
          _Pragma("unroll") for (int i = 0; i < 4; ++i) { x1[i] = zero_hist ? (f32x2_t){0.f, 0.f} : x1[i]; x2[i] = zero_hist ? (f32x2_t){0.f, 0.f} : x2[i]; x3[i] = zero_hist ? (f32x2_t){0.f, 0.f} : x3[i]; } } while (0)
#define CROWS(t, R, blk, W) do { bf16_t* dst_ = (((t) == 0) ? QN : ((t) == 1) ? KN : VN) + (m0 + 16 * g4 + (blk) * 8) * 1024 + h * 128 + c8; \
          _Pragma("unroll") for (int j_ = 0; j_ < 8; ++j_) { f32x2_t x0[4]; UNPK(x0, R[j_]); f32x2_t y[4]; f32x2_t ss2 = {0.f, 0.f}; \
          _Pragma("unroll") for (int i = 0; i < 4; ++i) { f32x2_t a = W[0][i] * x3[i]; a = __builtin_elementwise_fma(W[1][i], x2[i], a); a = __builtin_elementwise_fma(W[2][i], x1[i], a); a = __builtin_elementwise_fma(W[3][i], x0[i], a); \
              f32x2_t e = a * (f32x2_t){-LOG2E, -LOG2E}; e = (f32x2_t){__builtin_amdgcn_exp2f(e.x), __builtin_amdgcn_exp2f(e.y)} + (f32x2_t){1.f, 1.f}; \
              a = a * (f32x2_t){__builtin_amdgcn_rcpf(e.x), __builtin_amdgcn_rcpf(e.y)}; y[i] = a; ss2 = __builtin_elementwise_fma(a, a, ss2); x3[i] = x2[i]; x2[i] = x1[i]; x1[i] = x0[i]; } \
          float ss = rsum16(ss2.x + ss2.y); \
          const float sc_ = ((t) < 2) ? (((t) == 0) ? 0.08838834764831845f : 1.f) * frsq(ss + RMS_EPS) : 1.f; \
          const f32x2_t sc2 = {sc_, sc_}; const f32x2_t y0 = y[0] * sc2, y1 = y[1] * sc2, y2 = y[2] * sc2, y3 = y[3] * sc2; \
          u32x4 o; o.x = cvtpk(y0.x, y0.y); o.y = cvtpk(y1.x, y1.y); o.z = cvtpk(y2.x, y2.y); o.w = cvtpk(y3.x, y3.y); \
          *(u32x4*)(dst_ + (size_t)j_ * 1024) = o; } } while (0)
      CINIT();
      CROWS(0, rawA, 0, wA);
      CFENCE(); CLOADH(1); CLOADW(1, wB); CLOAD(1, rawA, 0); CFENCE();
      CROWS(0, rawB, 1, wA);
      CFENCE(); CLOAD(1, rawB, 1); CFENCE();
      CINIT();
      CROWS(1, rawA, 0, wB);
      CROWS(1, rawB, 1, wB);
      asm volatile("s_waitcnt vmcnt(0)" ::: "memory"); }
    bf16x8 kf[2][8], qf[2][8];
    { const bf16_t* kp = KN + (m0 + r32) * 1024 + h * 128 + hi * 8;
#pragma unroll
      for (int s = 0; s < 8; ++s) { kf[0][s] = *(const bf16x8*)(kp + s * 16); kf[1][s] = *(const bf16x8*)(kp + (size_t)32 * 1024 + s * 16); }
      const bf16_t* qp = QN + (m0 + r32) * 1024 + h * 128 + hi * 8;
#pragma unroll
      for (int s = 0; s < 8; ++s) { qf[0][s] = *(const bf16x8*)(qp + s * 16); qf[1][s] = *(const bf16x8*)(qp + (size_t)32 * 1024 + s * 16); } }
    const float Gj0 = Gt[r32], Gj1 = Gt[32 + r32];
    { f32x16 c00 = {}, c10 = {}, c11 = {};
#pragma unroll
      for (int s = 0; s < 8; ++s) { c00 = __builtin_amdgcn_mfma_f32_32x32x16_bf16(kf[0][s], kf[0][s], c00, 0, 0, 0);
          c10 = __builtin_amdgcn_mfma_f32_32x32x16_bf16(kf[1][s], kf[0][s], c10, 0, 0, 0); c11 = __builtin_amdgcn_mfma_f32_32x32x16_bf16(kf[1][s], kf[1][s], c11, 0, 0, 0); }
#pragma unroll
      for (int q = 0; q < 4; ++q) {
          const f32x4 gA = *(const f32x4*)(Gt + 8 * q + 4 * hi), bA = *(const f32x4*)(Bt + 8 * q + 4 * hi), gB = *(const f32x4*)(Gt + 32 + 8 * q + 4 * hi), bB = *(const f32x4*)(Bt + 32 + 8 * q + 4 * hi);
#pragma unroll
          for (int e = 0; e < 4; ++e) { const int r = 4 * q + e, il0 = 8 * q + e, il = il0 + 4 * hi;
              const int o0 = hi ? ro4(il0 + 4) : ro4(il0), o1 = hi ? ro4(32 + il0 + 4) : ro4(32 + il0);
              if (r32 < il) Lp[o0 + r32] = bA[e] * c00[r] * __expf(gA[e] - Gj0);
              Lp[o1 + r32] = bB[e] * c10[r] * __expf(gB[e] - Gj0);
              if (r32 < il) Lp[o1 + 32 + r32] = bB[e] * c11[r] * __expf(gB[e] - Gj1); } } }
    { f32x16 d00 = {}, d10 = {}, d11 = {};
#pragma unroll
      for (int s = 0; s < 8; ++s) { const bf16x8 q0 = qf[0][s], q1 = qf[1][s];
          d00 = __builtin_amdgcn_mfma_f32_32x32x16_bf16(q0, kf[0][s], d00, 0, 0, 0);
          d10 = __builtin_amdgcn_mfma_f32_32x32x16_bf16(q1, kf[0][s], d10, 0, 0, 0); d11 = __builtin_amdgcn_mfma_f32_32x32x16_bf16(q1, kf[1][s], d11, 0, 0, 0); }
      bf16_t* qs_ = (bf16_t*)stg;
#pragma unroll
      for (int q = 0; q < 4; ++q) {
          const f32x4 gA = *(const f32x4*)(Gt + 8 * q + 4 * hi), gB = *(const f32x4*)(Gt + 32 + 8 * q + 4 * hi);
#pragma unroll
          for (int e = 0; e < 4; ++e) { const int r = 4 * q + e, il = 8 * q + e + 4 * hi;
          const float v00 = (r32 <= il) ? d00[r] * __expf(gA[e] - Gj0) : 0.f;
          const float v10 = d10[r] * __expf(gB[e] - Gj0);
          const float v11 = (r32 <= il) ? d11[r] * __expf(gB[e] - Gj1) : 0.f;
          qs_[il * 64 + r32] = (bf16_t)(cvtpk(v00, 0.f) & 0xffffu); qs_[il * 64 + 32 + r32] = (bf16_t)0;
          qs_[(32 + il) * 64 + r32] = (bf16_t)(cvtpk(v10, 0.f) & 0xffffu); qs_[(32 + il) * 64 + 32 + r32] = (bf16_t)(cvtpk(v11, 0.f) & 0xffffu); } }
      asm volatile("s_waitcnt lgkmcnt(0)" ::: "memory");
      const __amdgpu_buffer_rsrc_t rsQK = MKRS(qkbuf(F) + m0 * 512 + h * 64);
      const unsigned offQ = (unsigned)(((lane >> 3) * 512 + (lane & 7) * 8) * 2);
#pragma unroll
      for (int i = 0; i < 8; ++i) { const int e = i * 64 + lane, row = e >> 3, c = e & 7; bst128(*(const u32x4*)(stg + row * 128 + c * 16), rsQK, offQ, i * 8 * 512 * 2); } }
    asm volatile("s_waitcnt lgkmcnt(0)" ::: "memory");
    CLOADH(2); CLOADW(2, wA); CLOAD(2, rawA, 0); CLOAD(2, rawB, 1);
    CFENCE();
    float T[64];
    {
    constexpr int NCH = 528;
    f32x4 ring[8];
#pragma unroll
    for (int c = 0; c < 8; ++c) ring[c] = *(const f32x4*)(Lp + 4 * c);
    asm volatile("" ::: "memory");
    T[0] = (lane == 0) ? 1.f : 0.f;
#pragma unroll
    for (int i = 1; i < 64; ++i) { float acc = (lane == i) ? 1.f : 0.f;
#pragma unroll
        for (int q4 = 0; q4 < (i + 3) / 4; ++q4) { const int c = ro4(i) / 4 + q4; const f32x4 l4 = ring[c & 7];
#pragma unroll
            for (int e = 0; e < 4; ++e) if (4 * q4 + e < i) acc -= l4[e] * T[4 * q4 + e];
            if (c + 8 < NCH) { ring[c & 7] = *(const f32x4*)(Lp + 4 * (c + 8)); asm volatile("" ::: "memory"); } }
        T[i] = acc; }
    asm volatile("" : "+v"(T[63]) :: "memory"); }
    asm volatile("s_waitcnt lgkmcnt(0)" ::: "memory");
    const int vb0 = (int)(uintptr_t)stg + v_rd_base(lane);
    const float betac = Bt[lane], gcc = Gt[lane];
#pragma unroll
    for (int i = 0; i < 64; ++i) *(bf16_t*)(Tl + i * LT_PITCH + lane * 2) = (bf16_t)(cvtpk(T[i] * betac, 0.f) & 0xffffu);
    u32x4 vout[16];
#define CROWSV(R, blk, W) do { _Pragma("unroll") for (int j_ = 0; j_ < 8; ++j_) { f32x2_t x0[4]; UNPK(x0, R[j_]); f32x2_t y[4]; \
          _Pragma("unroll") for (int i = 0; i < 4; ++i) { f32x2_t a = W[0][i] * x3[i]; a = __builtin_elementwise_fma(W[1][i], x2[i], a); a = __builtin_elementwise_fma(W[2][i], x1[i], a); a = __builtin_elementwise_fma(W[3][i], x0[i], a); \
              f32x2_t e = a * (f32x2_t){-LOG2E, -LOG2E}; e = (f32x2_t){__builtin_amdgcn_exp2f(e.x), __builtin_amdgcn_exp2f(e.y)} + (f32x2_t){1.f, 1.f}; \
              a = a * (f32x2_t){__builtin_amdgcn_rcpf(e.x), __builtin_amdgcn_rcpf(e.y)}; y[i] = a; x3[i] = x2[i]; x2[i] = x1[i]; x1[i] = x0[i]; } \
          u32x4 o; o.x = cvtpk(y[0].x, y[0].y); o.y = cvtpk(y[1].x, y[1].y); o.z = cvtpk(y[2].x, y[2].y); o.w = cvtpk(y[3].x, y[3].y); vout[(blk) * 8 + j_] = o; } } while (0)
    CINIT();
    CROWSV(rawA, 0, wA);
    CROWSV(rawB, 1, wA);
#undef CROWSV
#undef CLOAD
#undef CLOADH
#undef CLOADW
#undef CINIT
#undef CROWS
#undef CFENCE
#undef UNPK
#pragma unroll
    for (int pass = 0; pass < 2; ++pass) {
        const float egc = __expf(gcc);
        const __amdgpu_buffer_rsrc_t rsX = MKRS((pass == 0 ? VN : KN) + m0 * 1024 + h * 128);
        const __amdgpu_buffer_rsrc_t rsW = MKRS(wbuf(F) + m0 * 1024 + h * 128);
        const unsigned offU = (unsigned)(((lane >> 3) * 1024 + ((lane >> 2) & 1) * 64 + (lane & 3) * 8) * 2);
        if (pass == 1) {
#pragma unroll
            for (int i = 0; i < 64; ++i) { bf16_t* tp = (bf16_t*)(Tl + i * LT_PITCH + lane * 2); *tp = (bf16_t)(cvtpk(__uint_as_float((unsigned)*tp << 16) * egc, 0.f) & 0xffffu); } }
        f32x16 acc0[4], acc1[4];
        bf16x8 xst[8];
#define STAGE_LOAD(hf) do { _Pragma("unroll") for (int i8 = 0; i8 < 8; ++i8) { xst[i8] = __builtin_bit_cast(bf16x8, bld128(rsX, offS, (32 * (hf) + 4 * i8) * 2048)); } } while (0)
#define STAGE_WRITE() do { _Pragma("unroll") for (int i8 = 0; i8 < 8; ++i8) { const int tok = 4 * i8 + (lane >> 4), c8 = (lane & 15) * 8; \
            *(bf16x8*)(stg + v_st(tok, c8)) = xst[i8]; } asm volatile("s_waitcnt lgkmcnt(0)" ::: "memory"); } while (0)
#define TRRD(dst, off) asm volatile("ds_read_b64_tr_b16 %0, %1 offset:%2" : "=&v"(dst) : "v"(vb0), "i"(off) : "memory")
#define MM_HALF(ACC, ib, kh) do { _Pragma("unroll") for (int d0 = 0; d0 < 4; ++d0) { s16x4 l0, h0, l1, h1; \
            if (d0 == 0) { TRRD(l0, 0); TRRD(h0, 2048); TRRD(l1, 4096); TRRD(h1, 6144); } else if (d0 == 1) { TRRD(l0, 512); TRRD(h0, 512 + 2048); TRRD(l1, 512 + 4096); TRRD(h1, 512 + 6144); } \
            else if (d0 == 2) { TRRD(l0, 1024); TRRD(h0, 1024 + 2048); TRRD(l1, 1024 + 4096); TRRD(h1, 1024 + 6144); } else { TRRD(l0, 1536); TRRD(h0, 1536 + 2048); TRRD(l1, 1536 + 4096); TRRD(h1, 1536 + 6144); } \
            const bf16x8 a0 = *(const bf16x8*)(Tl + (32 * (ib) + r32) * LT_PITCH + (16 * (2 * (kh)) + 8 * hi) * 2), a1 = *(const bf16x8*)(Tl + (32 * (ib) + r32) * LT_PITCH + (16 * (2 * (kh) + 1) + 8 * hi) * 2); \
            asm volatile("s_waitcnt lgkmcnt(0)" ::: "memory"); __builtin_amdgcn_sched_barrier(0); \
            ACC[d0] = __builtin_amdgcn_mfma_f32_32x32x16_bf16(a0, (bf16x8){l0[0], l0[1], l0[2], l0[3], h0[0], h0[1], h0[2], h0[3]}, ACC[d0], 0, 0, 0); \
            ACC[d0] = __builtin_amdgcn_mfma_f32_32x32x16_bf16(a1, (bf16x8){l1[0], l1[1], l1[2], l1[3], h1[0], h1[1], h1[2], h1[3]}, ACC[d0], 0, 0, 0); } } while (0)
#define STORE_OUT(ACC, ib) do { bf16_t* so_ = (bf16_t*)stg; _Pragma("unroll") for (int d0 = 0; d0 < 4; ++d0) _Pragma("unroll") for (int r = 0; r < 16; ++r) so_[crow(r, hi) * 128 + d0 * 32 + r32] = (bf16_t)(cvtpk(ACC[d0][r], 0.f) & 0xffffu); \
            asm volatile("s_waitcnt lgkmcnt(0)" ::: "memory"); \
            _Pragma("unroll") for (int i = 0; i < 8; ++i) { const int e = i * 64 + lane, row = e >> 4, c = e & 15; bst128(*(const u32x4*)(stg + row * 256 + c * 16), rsW, offS, (32 * (ib) + 4 * i) * 2048); } \
            asm volatile("s_waitcnt lgkmcnt(0)" ::: "memory"); } while (0)
#define STORE_UT(ACC, ib) do { _Pragma("unroll") for (int d0 = 0; d0 < 4; ++d0) _Pragma("unroll") for (int q_ = 0; q_ < 4; ++q_) { \
            u32x2 w_; w_.x = cvtpk(ACC[d0][4 * q_], ACC[d0][4 * q_ + 1]); w_.y = cvtpk(ACC[d0][4 * q_ + 2], ACC[d0][4 * q_ + 3]); \
            *(u32x2*)(stg + (d0 * 32 + r32) * 64 + (8 * q_ + 4 * hi) * 2) = w_; } \
            asm volatile("s_waitcnt lgkmcnt(0)" ::: "memory"); \
            _Pragma("unroll") for (int i = 0; i < 8; ++i) { const int e = i * 64 + lane, v_ = e >> 2, c = e & 3; \
                bst128(*(const u32x4*)(stg + v_ * 64 + c * 16), rsV, offU, (8 * i * 1024 + (ib) * 32) * 2); } \
            asm volatile("s_waitcnt lgkmcnt(0)" ::: "memory"); } while (0)
#define VWRITE(hf) do { if ((g4 >> 1) == (hf)) { _Pragma("unroll") for (int r_ = 0; r_ < 16; ++r_) *(u32x4*)(stg + v_st(16 * (g4 & 1) + r_, c8)) = vout[r_]; } asm volatile("s_waitcnt lgkmcnt(0)" ::: "memory"); } while (0)
        if (pass == 0) { VWRITE(0); } else { STAGE_LOAD(0); STAGE_WRITE(); }
        asm volatile("" ::: "memory");
#pragma unroll
        for (int d0 = 0; d0 < 4; ++d0) { acc0[d0] = f32x16{}; acc1[d0] = f32x16{}; }
        MM_HALF(acc0, 0, 0);
        MM_HALF(acc1, 1, 0);
        asm volatile("s_waitcnt lgkmcnt(0)" ::: "memory");
        if (pass == 1) { STORE_OUT(acc0, 0); STAGE_LOAD(1); STAGE_WRITE(); }
        else { VWRITE(1); }
        MM_HALF(acc1, 1, 1);
        asm volatile("s_waitcnt lgkmcnt(0)" ::: "memory");
        if (pass == 1) { STORE_OUT(acc1, 1); } else { STORE_UT(acc0, 0); STORE_UT(acc1, 1); }
#undef STORE_UT

#undef STAGE_LOAD
#undef STAGE_WRITE
#undef VWRITE
#undef TRRD
#undef MM_HALF
#undef STORE_OUT
    }
}

constexpr int S_WP = 272, S_QKP = 144, S_KP = 288, S_OP = 272;
constexpr int S_WL = 0, S_QL = 64 * S_WP, S_KL = 2 * 64 * S_WP, S_QKL = S_KL + 64 * S_KP, S_BUF = S_QKL + 64 * S_QKP;
constexpr int S_OT = 2 * S_BUF, S_OTSZ = 64 * S_OP, S_TAB = S_OT + 2 * S_OTSZ, S_TABSZ = 528, S_END = S_TAB + 2 * S_TABSZ;
static_assert(S_END <= LDS_BARST, "scan LDS map");
typedef unsigned long long u64_t;
__device__ __forceinline__ bf16x8 frag2(const char* p0, const char* p1) { const u64_t a = *(const u64_t*)p0, b = *(const u64_t*)p1; typedef u64_t u64x2 __attribute__((ext_vector_type(2))); const u64x2 w = {a, b}; return __builtin_bit_cast(bf16x8, w); }
__device__ __forceinline__ void scan_mfma(Ctx& F, char* lds, int layer, int bh) {
    const int tid_ = fresh_tid(F.wave);
    const int tid = tid_, lane = tid & 63, wave = F.wave, fr = lane & 15, g = lane >> 4;
    const bool is_compute = wave < 4;
    const int b = bh >> 3, h = bh & 7;
    const bf16_t* QN = (const bf16_t*)F.out; const bf16_t* KN = (const bf16_t*)((const char*)F.out + 32 * MiB); const bf16_t* UT = (const bf16_t*)(F.ws + WS_VN);
    const float* GB = (const float*)(F.ws + WS_GB); const bf16_t* PROJ = (const bf16_t*)(F.ws + WS_PROJ); bf16_t* MIXED = (bf16_t*)(F.ws + WS_MIXED);
    const size_t mb0 = (size_t)b * SEQ;
    const int vb = (wave & 3) * 32;
    f32x4 Sacc[2][8];
#pragma unroll
    for (int c = 0; c < 2; ++c)
#pragma unroll
        for (int d = 0; d < 8; ++d) Sacc[c][d] = (f32x4){0.f, 0.f, 0.f, 0.f};
    const __amdgpu_buffer_rsrc_t rsU = __builtin_amdgcn_make_buffer_rsrc((void*)UT, 0, 0x02000000, 0x00020000);
    unsigned offU[2];
#pragma unroll
    for (int c = 0; c < 2; ++c) { const int v = vb + 16 * c + fr; offU[c] = (unsigned)((((v >> 1) * 1024 + (v & 1) * 64) + 4 * g) * 2); }
    u32x2 uA[2][4], uB[2][4];
#define ULOAD(dst, nn) do { const unsigned so_ = (unsigned)(((mb0 + (size_t)(nn) * 64) * 1024 + h * 128) * 2); _Pragma("unroll") for (int c = 0; c < 2; ++c) _Pragma("unroll") for (int t = 0; t < 4; ++t) \
        dst[c][t] = __builtin_bit_cast(u32x2, __builtin_amdgcn_raw_buffer_load_b64(rsU, offU[c] + 32u * t, so_, 0)); } while (0)
    const int t2 = tid - 256;
    const int r0 = t2 >> 4, c0 = t2 & 15, rq = t2 >> 3, cq = t2 & 7;
    u32x4 pw[4], pq[4], pk[4], pqk[2]; float pg = 0.f, pgl = 0.f;
    const unsigned offN = (unsigned)((r0 * 1024 + c0 * 8) * 2), offQK = (unsigned)((rq * 512 + cq * 8) * 2);
#define SLOADC(nn) do { const char* wc_ = (const char*)(wbuf(F) + (mb0 + (size_t)(nn) * 64) * 1024 + h * 128); const char* qc_ = (const char*)(QN + (mb0 + (size_t)(nn) * 64) * 1024 + h * 128); \
        const char* kc_ = (const char*)(KN + (mb0 + (size_t)(nn) * 64) * 1024 + h * 128); const char* qkc_ = (const char*)(qkbuf(F) + (mb0 + (size_t)(nn) * 64) * 512 + h * 64); \
        _Pragma("unroll") for (int i = 0; i < 4; ++i) { pw[i] = *(const u32x4*)(wc_ + offN + (unsigned)(i * 16 * 1024 * 2)); pq[i] = *(const u32x4*)(qc_ + offN + (unsigned)(i * 16 * 1024 * 2)); pk[i] = *(const u32x4*)(kc_ + offN + (unsigned)(i * 16 * 1024 * 2)); } \
        pqk[0] = *(const u32x4*)(qkc_ + offQK); pqk[1] = *(const u32x4*)(qkc_ + offQK + 32u * 512u * 2u); \
        if (t2 < 64) { const char* gc_ = (const char*)(GB + (mb0 + (size_t)(nn) * 64) * 16 + h); pg = *(const float*)(gc_ + t2 * 64); pgl = *(const float*)(gc_ + 63 * 64); } } while (0)
#define SWRITEC(bufo, tabo) do { char* B_ = lds + (bufo); _Pragma("unroll") for (int i = 0; i < 4; ++i) { const int row = r0 + 16 * i; \
        *(u32x4*)(B_ + S_WL + row * S_WP + c0 * 16) = pw[i]; *(u32x4*)(B_ + S_QL + row * S_WP + c0 * 16) = pq[i]; *(u32x4*)(B_ + S_KL + row * S_KP + c0 * 16) = pk[i]; } \
        *(u32x4*)(B_ + S_QKL + rq * S_QKP + cq * 16) = pqk[0]; *(u32x4*)(B_ + S_QKL + (rq + 32) * S_QKP + cq * 16) = pqk[1]; \
        if (t2 < 64) { float* T_ = (float*)(lds + (tabo)); T_[t2] = __expf(pg); T_[64 + t2] = __expf(pgl - pg); if (t2 == 0) T_[128] = __expf(pgl); } } while (0)
    const int orow = t2 >> 2, oseg = t2 & 3;
    u32x4 zA[4], zB[4];
#define ZLOAD(dst, nn) do { const char* zc_ = (const char*)(PROJ + pj(mb0 + (size_t)(nn) * 64 + orow, C_GZ + h * 128 + oseg * 32)); _Pragma("unroll") for (int i = 0; i < 4; ++i) dst[i] = *(const u32x4*)(zc_ + i * 16); } while (0)
    float nwv[32];
    if (!is_compute) {
#pragma unroll
        for (int i = 0; i < 32; ++i) nwv[i] = F.gdn_norm_w[layer * 128 + oseg * 32 + i];
    }
#define OUTPUT(nn, OTO, Z) do { const char* op_ = lds + (OTO) + orow * S_OP + oseg * 64; float ov[32]; float ss = 0.f; \
        _Pragma("unroll") for (int i = 0; i < 4; ++i) { const u32x4 w = *(const u32x4*)(op_ + i * 16); ov[8 * i] = bf_lo(w.x); ov[8 * i + 1] = bf_hi(w.x); ov[8 * i + 2] = bf_lo(w.y); ov[8 * i + 3] = bf_hi(w.y); \
            ov[8 * i + 4] = bf_lo(w.z); ov[8 * i + 5] = bf_hi(w.z); ov[8 * i + 6] = bf_lo(w.w); ov[8 * i + 7] = bf_hi(w.w); } \
        _Pragma("unroll") for (int i = 0; i < 32; ++i) ss = __builtin_fmaf(ov[i], ov[i], ss); \
        ss += shx<1>(ss); ss += shx<2>(ss); \
        const float rs = frsq(ss * (1.0f / 128.0f) + RMS_EPS); \
        bf16_t* dp_ = MIXED + pj2(mb0 + (size_t)(nn) * 64 + orow, 1024 + h * 128 + oseg * 32); \
        _Pragma("unroll") for (int i = 0; i < 4; ++i) { const u32x4 z = Z[i]; u32x4 o; \
            o.x = cvtpk(ov[8 * i] * rs * nwv[8 * i] * bf_lo(z.x), ov[8 * i + 1] * rs * nwv[8 * i + 1] * bf_hi(z.x)); o.y = cvtpk(ov[8 * i + 2] * rs * nwv[8 * i + 2] * bf_lo(z.y), ov[8 * i + 3] * rs * nwv[8 * i + 3] * bf_hi(z.y)); \
            o.z = cvtpk(ov[8 * i + 4] * rs * nwv[8 * i + 4] * bf_lo(z.z), ov[8 * i + 5] * rs * nwv[8 * i + 5] * bf_hi(z.z)); o.w = cvtpk(ov[8 * i + 6] * rs * nwv[8 * i + 6] * bf_lo(z.w), ov[8 * i + 7] * rs * nwv[8 * i + 7] * bf_hi(z.w)); \
            *(u32x4*)(dp_ + i * 8) = o; } } while (0)
#define COMPUTE_STEP(n, CUR, UC, UN) do { \
        if ((n) + 1 < 64) { ULOAD(UN, (n) + 1); } \
        const char* Wl = lds + (CUR) * S_BUF + S_WL; const char* Ql = lds + (CUR) * S_BUF + S_QL; const char* Kl = lds + (CUR) * S_BUF + S_KL; const char* QKl = lds + (CUR) * S_BUF + S_QKL; \
        const float* EG = (const float*)(lds + S_TAB + (CUR) * S_TABSZ); const float* E2 = EG + 64; char* Ot = lds + S_OT + (CUR) * S_OTSZ; \
          \
        bf16x8 sb[2][4]; \
        _Pragma("unroll") for (int c = 0; c < 2; ++c) _Pragma("unroll") for (int s = 0; s < 4; ++s) { \
            const u32x4 w = {cvtpk(Sacc[c][2 * s][0], Sacc[c][2 * s][1]), cvtpk(Sacc[c][2 * s][2], Sacc[c][2 * s][3]), cvtpk(Sacc[c][2 * s + 1][0], Sacc[c][2 * s + 1][1]), cvtpk(Sacc[c][2 * s + 1][2], Sacc[c][2 * s + 1][3])}; \
            sb[c][s] = __builtin_bit_cast(bf16x8, w); } \
          \
        f32x4 vn[2][4], oo[2][4]; \
        bf16x8 wa[4], qa[4]; \
        _Pragma("unroll") for (int s = 0; s < 4; ++s) { const char* wr_ = Wl + fr * S_WP + 8 * g; const char* qr_ = Ql + fr * S_WP + 8 * g; wa[s] = frag2(wr_ + 64 * s, wr_ + 64 * s + 32); qa[s] = frag2(qr_ + 64 * s, qr_ + 64 * s + 32); } \
        _Pragma("unroll") for (int t = 0; t < 4; ++t) { \
            float eg4[4]; \
            _Pragma("unroll") for (int ii = 0; ii < 4; ++ii) eg4[ii] = EG[16 * t + 4 * g + ii]; \
            __builtin_amdgcn_sched_barrier(0); \
            f32x4 a1[2], a2[2]; \
            _Pragma("unroll") for (int c = 0; c < 2; ++c) { a1[c] = (f32x4){0.f, 0.f, 0.f, 0.f}; a2[c] = (f32x4){0.f, 0.f, 0.f, 0.f}; } \
            _Pragma("unroll") for (int s = 0; s < 4; ++s) _Pragma("unroll") for (int c = 0; c < 2; ++c) a1[c] = __builtin_amdgcn_mfma_f32_16x16x32_bf16(wa[s], sb[c][s], a1[c], 0, 0, 0); \
            __builtin_amdgcn_sched_barrier(0); \
            if (t < 3) { _Pragma("unroll") for (int s = 0; s < 4; ++s) { const char* wr_ = Wl + (16 * (t + 1) + fr) * S_WP + 8 * g; wa[s] = frag2(wr_ + 64 * s, wr_ + 64 * s + 32); } } \
            __builtin_amdgcn_sched_barrier(0); \
            _Pragma("unroll") for (int s = 0; s < 4; ++s) _Pragma("unroll") for (int c = 0; c < 2; ++c) a2[c] = __builtin_amdgcn_mfma_f32_16x16x32_bf16(qa[s], sb[c][s], a2[c], 0, 0, 0); \
            __builtin_amdgcn_sched_barrier(0); \
            if (t < 3) { _Pragma("unroll") for (int s = 0; s < 4; ++s) { const char* qr_ = Ql + (16 * (t + 1) + fr) * S_WP + 8 * g; qa[s] = frag2(qr_ + 64 * s, qr_ + 64 * s + 32); } } \
            _Pragma("unroll") for (int c = 0; c < 2; ++c) { const u32x2 uw = UC[c][t]; const float u0 = bf_lo(uw.x), u1 = bf_hi(uw.x), u2 = bf_lo(uw.y), u3 = bf_hi(uw.y); \
                vn[c][t] = (f32x4){u0 - a1[c][0], u1 - a1[c][1], u2 - a1[c][2], u3 - a1[c][3]}; \
                oo[c][t] = (f32x4){a2[c][0] * eg4[0], a2[c][1] * eg4[1], a2[c][2] * eg4[2], a2[c][3] * eg4[3]}; } } \
          \
        bf16x8 vb2[2][2], vb3[2][2]; \
        { _Pragma("unroll") for (int s2 = 0; s2 < 2; ++s2) { float e2v[8]; \
            _Pragma("unroll") for (int ii = 0; ii < 4; ++ii) { e2v[ii] = E2[32 * s2 + 4 * g + ii]; e2v[4 + ii] = E2[32 * s2 + 16 + 4 * g + ii]; } \
            _Pragma("unroll") for (int c = 0; c < 2; ++c) { \
            const u32x4 w = {cvtpk(vn[c][2 * s2][0], vn[c][2 * s2][1]), cvtpk(vn[c][2 * s2][2], vn[c][2 * s2][3]), cvtpk(vn[c][2 * s2 + 1][0], vn[c][2 * s2 + 1][1]), cvtpk(vn[c][2 * s2 + 1][2], vn[c][2 * s2 + 1][3])}; \
            vb2[c][s2] = __builtin_bit_cast(bf16x8, w); \
            const u32x4 w3 = {cvtpk(vn[c][2 * s2][0] * e2v[0], vn[c][2 * s2][1] * e2v[1]), cvtpk(vn[c][2 * s2][2] * e2v[2], vn[c][2 * s2][3] * e2v[3]), \
                              cvtpk(vn[c][2 * s2 + 1][0] * e2v[4], vn[c][2 * s2 + 1][1] * e2v[5]), cvtpk(vn[c][2 * s2 + 1][2] * e2v[6], vn[c][2 * s2 + 1][3] * e2v[7])}; \
            vb3[c][s2] = __builtin_bit_cast(bf16x8, w3); } } \
          __builtin_amdgcn_sched_barrier(0); \
          { const char* ar0 = QKl + fr * S_QKP + 8 * g; const bf16x8 f0 = frag2(ar0, ar0 + 32), f1 = frag2(ar0 + 16 * S_QKP, ar0 + 16 * S_QKP + 32); \
            _Pragma("unroll") for (int c = 0; c < 2; ++c) { oo[c][0] = __builtin_amdgcn_mfma_f32_16x16x32_bf16(f0, vb2[c][0], oo[c][0], 0, 0, 0); oo[c][1] = __builtin_amdgcn_mfma_f32_16x16x32_bf16(f1, vb2[c][0], oo[c][1], 0, 0, 0); } } \
          __builtin_amdgcn_sched_barrier(0); \
          { const char* ar2 = QKl + (32 + fr) * S_QKP + 8 * g; const bf16x8 f0 = frag2(ar2, ar2 + 32), f1 = frag2(ar2 + 64, ar2 + 96), f2 = frag2(ar2 + 16 * S_QKP, ar2 + 16 * S_QKP + 32), f3 = frag2(ar2 + 16 * S_QKP + 64, ar2 + 16 * S_QKP + 96); \
            _Pragma("unroll") for (int c = 0; c < 2; ++c) { oo[c][2] = __builtin_amdgcn_mfma_f32_16x16x32_bf16(f0, vb2[c][0], oo[c][2], 0, 0, 0); oo[c][3] = __builtin_amdgcn_mfma_f32_16x16x32_bf16(f2, vb2[c][0], oo[c][3], 0, 0, 0); \
                oo[c][2] = __builtin_amdgcn_mfma_f32_16x16x32_bf16(f1, vb2[c][1], oo[c][2], 0, 0, 0); oo[c][3] = __builtin_amdgcn_mfma_f32_16x16x32_bf16(f3, vb2[c][1], oo[c][3], 0, 0, 0); } } \
          __builtin_amdgcn_sched_barrier(0); } \
          \
        { const float aa = EG[128]; \
          const unsigned kaddr = (unsigned)(uintptr_t)Kl + (unsigned)((4 * g + ((lane & 15) >> 2)) * S_KP + (lane & 3) * 8); \
          _Pragma("unroll") for (int c = 0; c < 2; ++c) _Pragma("unroll") for (int db = 0; db < 8; ++db) Sacc[c][db] = Sacc[c][db] * aa; \
          _Pragma("unroll") for (int dp = 0; dp < 4; ++dp) { s16x4 klo[2][2], khi[2][2]; \
            _Pragma("unroll") for (int dd = 0; dd < 2; ++dd) _Pragma("unroll") for (int s2 = 0; s2 < 2; ++s2) { \
                asm volatile("ds_read_b64_tr_b16 %0, %1 offset:%2" : "=&v"(klo[dd][s2]) : "v"(kaddr), "i"(s2 * 32 * S_KP + (2 * dp + dd) * 32) : "memory"); \
                asm volatile("ds_read_b64_tr_b16 %0, %1 offset:%2" : "=&v"(khi[dd][s2]) : "v"(kaddr), "i"(s2 * 32 * S_KP + 16 * S_KP + (2 * dp + dd) * 32) : "memory"); } \
            asm volatile("s_waitcnt lgkmcnt(0)" ::: "memory"); __builtin_amdgcn_sched_barrier(0); \
            _Pragma("unroll") for (int s2 = 0; s2 < 2; ++s2) _Pragma("unroll") for (int dd = 0; dd < 2; ++dd) { const s16x4 lo_ = klo[dd][s2], hi_ = khi[dd][s2]; \
                const bf16x8 kfr = (bf16x8){lo_[0], lo_[1], lo_[2], lo_[3], hi_[0], hi_[1], hi_[2], hi_[3]}; \
                _Pragma("unroll") for (int c = 0; c < 2; ++c) Sacc[c][2 * dp + dd] = __builtin_amdgcn_mfma_f32_16x16x32_bf16(kfr, vb3[c][s2], Sacc[c][2 * dp + dd], 0, 0, 0); } \
            __builtin_amdgcn_sched_barrier(0); } } \
          \
        _Pragma("unroll") for (int c = 0; c < 2; ++c) _Pragma("unroll") for (int t = 0; t < 4; ++t) _Pragma("unroll") for (int ii = 0; ii < 4; ++ii) \
            *(bf16_t*)(Ot + (16 * t + 4 * g + ii) * S_OP + (vb + 16 * c + fr) * 2) = (bf16_t)(cvtpk(oo[c][t][ii], 0.f) & 0xffffu); \
    } while (0)
#define IO_STEP(n, NXT, ZC, ZN) do { \
        if ((n) + 1 < 64) { SWRITEC((NXT) * S_BUF, S_TAB + (NXT) * S_TABSZ); } \
        if ((n) < 64) { ZLOAD(ZN, (n)); } \
        if ((n) + 2 < 64) { SLOADC((n) + 2); } \
        if ((n) >= 1) { OUTPUT((n) - 1, S_OT + (NXT) * S_OTSZ, ZC); } \
    } while (0)
    if (is_compute) { ULOAD(uA, 0); }
    else { SLOADC(0); SWRITEC(0, S_TAB); SLOADC(1); }
    __syncthreads();
#define SCAN_BAR() do { asm volatile("s_waitcnt lgkmcnt(0)" ::: "memory"); __builtin_amdgcn_s_barrier(); asm volatile("" ::: "memory"); } while (0)
    if (is_compute) {
#pragma unroll 1
        for (int n = 0; n < 64; n += 2) {
            COMPUTE_STEP(n, 0, uA, uB); SCAN_BAR();
            COMPUTE_STEP(n + 1, 1, uB, uA); SCAN_BAR();
        }
    } else {
#pragma unroll 1
        for (int n = 0; n < 64; n += 2) {
            IO_STEP(n, 1, zB, zA); SCAN_BAR();
            IO_STEP(n + 1, 0, zA, zB); SCAN_BAR();
        }
        OUTPUT(63, S_OT + 1 * S_OTSZ, zB);
    }
#undef COMPUTE_STEP
#undef IO_STEP
#undef OUTPUT
#undef ZLOAD
#undef SLOADC
#undef SWRITEC
#undef ULOAD
}
}

#define XB_TMO      128
#define XB_XCNT(j)  (256  + 64 * (j))
#define XB_XSUB(j)  (1280 + 64 * (j))
#define XB_XGEN(j)  (2304 + 64 * (j))
#define XB_TOP      3328
#define XB_TOPGEN   3392
#define XCD_BAR_WORDS 3456
#define XB_SPIN_CAP (1u << 18)

__device__ __forceinline__ unsigned xb_ld(unsigned* p)              { return __hip_atomic_load(p, __ATOMIC_RELAXED, __HIP_MEMORY_SCOPE_AGENT); }
__device__ __forceinline__ unsigned xb_add(unsigned* p, unsigned v) { return __hip_atomic_fetch_add(p, v, __ATOMIC_RELAXED, __HIP_MEMORY_SCOPE_AGENT); }
__device__ __forceinline__ unsigned xb_xcc_id() { return (unsigned)__builtin_amdgcn_s_getreg((3 << 11) | 20) & 0xFu; }
#define XB_SPIN(cond, bar) do { unsigned _sp = 0; while (cond) { __builtin_amdgcn_s_sleep(1); \
    if ((++_sp & 255u) == 0u) { if (xb_ld(&(bar)[XB_TMO])) break; if (_sp > XB_SPIN_CAP) { atomicAdd(&(bar)[XB_TMO], 1u); break; } } } } while (0)

struct XcdBarrier {
    unsigned* bar; unsigned x;
    volatile LAS unsigned* st;
};

__device__ __forceinline__ XcdBarrier xcd_barrier_post(unsigned* bar, volatile LAS unsigned* st) {
    XcdBarrier b; b.bar = bar; b.x = xb_xcc_id(); b.st = st;
    if (threadIdx.x == 0) (void)xb_add(&bar[XB_XCNT(b.x)], 1u);
    return b;
}
__device__ __forceinline__ void xcd_barrier_complete(unsigned* bar, unsigned x, unsigned& nloc, unsigned& nx) {
    const unsigned G = gridDim.x * gridDim.y * gridDim.z;
    unsigned sum, cnt, mine, sp = 0u;
    for (;;) {
        sum = 0u; cnt = 0u; mine = 0u;
#pragma unroll
        for (unsigned j = 0; j < 16; ++j) { const unsigned c = xb_ld(&bar[XB_XCNT(j)]); sum += c; cnt += (c > 0u) ? 1u : 0u; mine = (j == x) ? c : mine; }
        if (sum == G) break;
        __builtin_amdgcn_s_sleep(1);
        if ((++sp & 255u) == 0u) { if (xb_ld(&bar[XB_TMO])) break; if (sp > XB_SPIN_CAP) { atomicAdd(&bar[XB_TMO], 1u); break; } }
    }
    nloc = mine > 0u ? mine : 1u; nx = cnt > 0u ? cnt : 1u;
}

__device__ __forceinline__ void xcd_barrier(const XcdBarrier& b, const int wave_id) {
    asm volatile("s_waitcnt vmcnt(0)" ::: "memory");
    __syncthreads();
    if (wave_id == 0 && b.st[0] == 0u) {
        const int l_ = fresh_tid(0);
        const unsigned G_ = gridDim.x * gridDim.y * gridDim.z;
        unsigned sum_, cnt_, mine_, sp_ = 0u;
        for (;;) {
            const unsigned c_ = (l_ < 16) ? xb_ld(&b.bar[XB_XCNT(l_)]) : 0u;
            sum_ = 0u; cnt_ = 0u;
#pragma unroll
            for (int j = 0; j < 16; ++j) { const unsigned cj = (unsigned)__builtin_amdgcn_readlane((int)c_, j); sum_ += cj; cnt_ += (cj > 0u) ? 1u : 0u; }
            mine_ = (unsigned)__builtin_amdgcn_readlane((int)c_, (int)b.x);
            if (sum_ == G_) break;
            __builtin_amdgcn_s_sleep(1);
            if ((++sp_ & 255u) == 0u) { if (__builtin_amdgcn_readfirstlane((int)xb_ld(&b.bar[XB_TMO]))) break; if (sp_ > XB_SPIN_CAP) { if (l_ == 0) atomicAdd(&b.bar[XB_TMO], 1u); break; } }
        }
        if (l_ == 0) { b.st[0] = mine_ > 0u ? mine_ : 1u; b.st[1] = cnt_ > 0u ? cnt_ : 1u; }
        asm volatile("s_waitcnt lgkmcnt(0)" ::: "memory");
    }
    if (fresh_tid(wave_id) == 0) {
        unsigned* bar = b.bar; asm volatile("" : "+s"(bar));
        __builtin_amdgcn_s_waitcnt(0);
        unsigned nloc = b.st[0], nx = b.st[1];
        if (nloc == 0u) { xcd_barrier_complete(bar, b.x, nloc, nx); b.st[0] = nloc; b.st[1] = nx; }
        const unsigned old = xb_add(&bar[XB_XSUB(b.x)], 1u);
        const unsigned gen = old / nloc;
        if (old + 1u == (gen + 1u) * nloc) {
            __builtin_amdgcn_fence(__ATOMIC_RELEASE, "agent");
            asm volatile("s_waitcnt vmcnt(0)" ::: "memory");
            const unsigned og = xb_add(&bar[XB_TOP], 1u);
            const unsigned tg = og / nx;
            if (og + 1u == (tg + 1u) * nx) xb_add(&bar[XB_TOPGEN], 1u);
            else XB_SPIN(xb_ld(&bar[XB_TOPGEN]) == tg, bar);
            __builtin_amdgcn_fence(__ATOMIC_ACQUIRE, "agent");
            xb_add(&bar[XB_XGEN(b.x)], 1u);
            asm volatile("s_waitcnt vmcnt(0)" ::: "memory");
        } else {
            XB_SPIN(xb_ld(&bar[XB_XGEN(b.x)]) == gen, bar);
            __builtin_amdgcn_fence(__ATOMIC_ACQUIRE, "agent");
            asm volatile("s_waitcnt vmcnt(0)" ::: "memory");
        }
    }
    __syncthreads();
}

__global__ void __launch_bounds__(512, 2) hybrid_fwd(Args args) {
    extern __shared__ __attribute__((aligned(16))) unsigned char lds[];
    cg::grid_group grid = cg::this_grid();
    Ctx F;
    F.tid = threadIdx.x; F.lane = F.tid & 63; F.wave = __builtin_amdgcn_readfirstlane(F.tid >> 6); F.bid = blockIdx.x; F.G = gridDim.x;
    F.x = args.in[0]; F.norm_w = args.in[1]; F.w_in = args.in[2]; F.w_out = args.in[3]; F.lq1 = args.in[4]; F.lk1 = args.in[5]; F.lq2 = args.in[6]; F.lk2 = args.in[7];
    F.subln_w = args.in[8]; F.rel_bias = args.in[9]; F.conv_w = args.in[10]; F.a_log = args.in[11]; F.dt_bias = args.in[12]; F.gdn_norm_w = args.in[13]; F.final_w = args.in[14];
    F.out = args.out; F.ws = args.ws;
    LAS unsigned char* ldsl = (LAS unsigned char*)lds;
    LAS float* rstd_l = (LAS float*)(ldsl + LDSX_OFF);
    volatile LAS unsigned* barst = (volatile LAS unsigned*)(ldsl + LDS_BARST);
    if (F.tid < 2) barst[F.tid] = 0u;
    __syncthreads();
    if (F.bid == 0) { u32x4* cw = (u32x4*)(F.ws + WS_CTL);
#pragma unroll
        for (int i = 0; i < 8; ++i) cw[i * 512 + F.tid] = (u32x4){0u, 0u, 0u, 0u}; }

    grid.sync();
    XcdBarrier bar = xcd_barrier_post((unsigned*)(F.ws + WS_CTL) + 4096, barst);
    for (int rep_ = 0; rep_ < REP_P0; ++rep_) p0_prologue(F, ldsl);
    xcd_barrier(bar, F.wave);

#pragma unroll 1
    for (int layer = 0; layer < 2; ++layer) {
        const float lambda_init = (layer == 0) ? 0.2f : 0.35550906759f;
        {
            relaunder(F);
#ifndef REP_BA
#define REP_BA 1
#endif
            for (int rb_ = 0; rb_ < REP_BA; ++rb_) ba_job(F, ldsl, layer);
            pg8::Gemm g{(const bf16_t*)(F.ws + WS_XB), (const bf16_t*)(F.ws + WS_WIN) + (size_t)layer * NPROJ * DM, M, NPROJ, DM};
            pg8::StaticOrder S; S.init(M, NPROJ, F.G, F.bid);
            pg8::Unit u0; S.next(0, u0);
            rstd_table(F, rstd_l, u0.pm * 256, 256);
            __syncthreads();
            pg8::EpiProj E{(bf16_t*)(F.ws + WS_PROJ), rstd_l, QSCALE};
            for (int rep_ = 0; rep_ < REP_P1; ++rep_) pg8::gemm_phase<pg8::EpiProj, pg8::StaticOrder, PG8_ALIGN_P1, PG8_SP2_ALL>(ldsl, g, S, E, F.wave);
        }
        xcd_barrier(bar, F.wave);
        relaunder(F);
        { const int gw = F.bid * 8 + F.wave; if (gw < 2048) gdn::chunk_prep(F, (char*)lds + F.wave * gdn::WAVE_LDS, layer, gw); }
        xcd_barrier(bar, F.wave);
        relaunder(F);
        { int bidv = F.bid; asm volatile("" : "+s"(bidv));
          if (bidv < 32) {
            for (int rep_ = 0; rep_ < REP_SCAN; ++rep_) gdn::scan_mfma(F, (char*)lds, layer, bidv);
          } }
        relaunder(F);
#ifdef PROBE_SERIAL
        xcd_barrier(bar, F.wave);
#endif
        {
            float d1 = F.lq1[layer * 64 + F.lane] * F.lk1[layer * 64 + F.lane], d2 = F.lq2[layer * 64 + F.lane] * F.lk2[layer * 64 + F.lane];
            d1 = wave_sum(d1); d2 = wave_sum(d2);
            const float lam = __int_as_float(__builtin_amdgcn_readfirstlane(__float_as_int(__expf(d1) - __expf(d2) + lambda_init)));
            unsigned* wq = (unsigned*)(F.ws + WS_CTL) + 8192 + layer * 64;
            volatile LAS unsigned* wql = (volatile LAS unsigned*)(ldsl + LDS_BARST + 16);
            bool have = false; int uraw = 0;
            for (;;) {
                if (!have) {
                    if (F.tid == 0) wql[0] = __hip_atomic_fetch_add(wq, 1u, __ATOMIC_RELAXED, __HIP_MEMORY_SCOPE_AGENT);
                    __syncthreads();
                    uraw = (int)wql[0];
                    __syncthreads(); }
                have = false;
                int u = uraw;
                if (layer == 0) {
                    constexpr int WB = 32, NWB = (P0_LAYER_ITEMS + WB - 1) / WB;
                    if (u < 4 * NWB && (u & 3) == 3) {
                        relaunder(F);
#pragma unroll 1
                        for (int k = 0; k < WB / 8; ++k) { const int it = (u >> 2) * WB + k * 8 + F.wave; if (it < P0_LAYER_ITEMS) p0_weight_item(F, (LAS float*)(ldsl + F.wave * 17408), 1, it); }
                        __syncthreads();
                        continue; }
                    u -= (u < 4 * NWB) ? (u >> 2) : NWB; }
                if (u >= 512) break;
                const int qb = 15 - (u >> 5), bh = u & 31;
                if (F.wave >= 4) att::attn_unit<true>(F, (char*)lds, layer, bh >> 3, bh & 7, qb, lam, 1.0f - lambda_init, wq, wql);
                else att::attn_unit<false>(F, (char*)lds, layer, bh >> 3, bh & 7, qb, lam, 1.0f - lambda_init, wq, wql);
                uraw = (int)wql[0]; have = true;
            }
        }
        xcd_barrier(bar, F.wave);
        {
            relaunder(F);
            pg8::Gemm g{(const bf16_t*)(F.ws + WS_MIXED), (const bf16_t*)(F.ws + WS_WOUT) + (size_t)layer * DM * DM, M, DM, DM};
            pg8::StaticOrder S; S.init(M, DM, F.G, F.bid);
            { pg8::EpiOut<true> E{nullptr, (bf16_t*)(F.ws + WS_XB), (float*)(F.ws + WS_ROWSQ)};
                pg8::gemm_phase<pg8::EpiOut<true>, pg8::StaticOrder, true, PG8_SP2_ALL>(ldsl, g, S, E, F.wave); }
        }
        xcd_barrier(bar, F.wave);
    }
    {
        relaunder(F);
        const int gw = F.bid * 8 + F.wave, NGW = F.G * 8; const float* RQ = (const float*)(F.ws + WS_ROWSQ);
        for (int m = gw; m < M; m += NGW) {
            float s = (F.lane < 32) ? RQ[(size_t)m * 32 + F.lane] : 0.f; s = wave_sum(s);
            const float rs = frsq(s * (1.0f / DM) + RMS_EPS);
            u32x2 xv8[8]; f32x4 w8[8];
            const bf16_t* xr = (const bf16_t*)(F.ws + WS_XB) + pj2((size_t)m, 4 * F.lane); f32x4* orow = (f32x4*)(F.out + (size_t)m * DM) + F.lane; const f32x4* wr_ = (const f32x4*)F.final_w + F.lane;
#pragma unroll
            for (int j = 0; j < 8; ++j) { xv8[j] = *(const u32x2*)(xr + (size_t)j * 8 * 2048); w8[j] = wr_[64 * j]; }
#pragma unroll
            for (int j = 0; j < 8; ++j) { const u32x2 xv = xv8[j]; const f32x4 w = w8[j];
                orow[64 * j] = (f32x4){bf_lo(xv.x) * rs * w[0], bf_hi(xv.x) * rs * w[1], bf_lo(xv.y) * rs * w[2], bf_hi(xv.y) * rs * w[3]}; }
        }
    }
}

extern "C" void kernel_launch(void* const* d_in, const int* in_sizes, int n_in, void* d_out, int out_size, void* d_ws, size_t ws_size, hipStream_t stream) {
    static int grid = 0;
    if (grid == 0) {
        if (n_in != 15 || in_sizes[0] != M * DM || out_size != M * DM || ws_size < WS_END) {
            fprintf(stderr, "kernel_launch: unexpected shapes (n_in %d, in0 %d, out %d, ws %zu < %zu)\n", n_in, n_in > 0 ? in_sizes[0] : -1, out_size, ws_size, (size_t)WS_END); grid = -1; return; }
        int dev = 0, cus = 0, per_cu = 0;
        (void)hipGetDevice(&dev); (void)hipDeviceGetAttribute(&cus, hipDeviceAttributeMultiprocessorCount, dev);
        if (hipFuncSetAttribute((const void*)hybrid_fwd, hipFuncAttributeMaxDynamicSharedMemorySize, LDS_BYTES) != hipSuccess) { fprintf(stderr, "kernel_launch: hipFuncSetAttribute failed\n"); grid = -1; return; }
        (void)hipOccupancyMaxActiveBlocksPerMultiprocessor(&per_cu, (const void*)hybrid_fwd, 512, LDS_BYTES);
        if (per_cu < 1) { fprintf(stderr, "kernel_launch: occupancy query says %d blocks per CU\n", per_cu); grid = -1; return; }
        grid = cus;
        if (grid != 256) fprintf(stderr, "kernel_launch: note: %d CUs (built for 256)\n", grid);
    }
    if (grid < 0) return;
    Args a{};
    for (int i = 0; i < 15; ++i) a.in[i] = (const float*)d_in[i];
    a.out = (float*)d_out; a.ws = (unsigned char*)d_ws;
    void* kargs[] = {&a};
    hipError_t e = hipLaunchCooperativeKernel((const void*)hybrid_fwd, dim3(grid), dim3(512), kargs, LDS_BYTES, stream);
    if (e != hipSuccess) fprintf(stderr, "kernel_launch: cooperative launch failed: %s\n", hipGetErrorString(e));
}
```
